# Optimizing an MI355X kernel written in HIP

```python
import math
import jax, jax.numpy as jnp
from jax import lax
import numpy as np

D_MODEL = 1024
BATCH = 8
SEQ = 4096
DEPTH = 4

GRID_W = 64
Q_BLOCK = 128
N_MIXERS = 3
A_HEADS = 16
A_KV_HEADS = 4
A_HEAD_DIM = D_MODEL // A_HEADS
AXIAL_THETA = 10000.0
FNET_GROUPS = 4
C_HEADS = 8
C_HEAD_DIM = D_MODEL // C_HEADS // 2
PARTIAL_ROPE_DIM = C_HEAD_DIM // 4
ROPE_THETA = 500000.0
D_FF = 2816
CONV_WIDTH = 3
DEEPNORM_ALPHA = (2.0 * DEPTH) ** 0.25
DEEPNORM_BETA = (8.0 * DEPTH) ** -0.25
LN_EPS = 1e-5
RMS_EPS = 1e-6

kernel_name = 'hybrid_interleaved_gqa_fnet_diffattn_encoder'


def _layernorm(x, g, b):
    x32 = x.astype(jnp.float32)
    mu = jnp.mean(x32, axis=-1, keepdims=True)
    var = jnp.mean(jnp.square(x32 - mu), axis=-1, keepdims=True)
    y = (x32 - mu) * lax.rsqrt(var + LN_EPS) * g.astype(jnp.float32) + b.astype(jnp.float32)
    return y.astype(x.dtype)


def _rmsnorm(x, g):
    x32 = x.astype(jnp.float32)
    y = x32 * lax.rsqrt(jnp.mean(jnp.square(x32), axis=-1, keepdims=True) + RMS_EPS) * g.astype(jnp.float32)
    return y.astype(x.dtype)


def _rope_cos_sin(pos, dim, theta):
    inv_freq = theta ** (-jnp.arange(0, dim, 2, dtype=jnp.float32) / dim)
    ang = pos.astype(jnp.float32)[:, None] * inv_freq[None, :]
    return jnp.cos(ang), jnp.sin(ang)


def _rotate_half(x, cos, sin):
    half = x.shape[-1] // 2
    shape = (cos.shape[0],) + (1,) * (x.ndim - 3) + (cos.shape[-1],)
    c = cos.reshape(shape).astype(x.dtype)
    s = sin.reshape(shape).astype(x.dtype)
    x1, x2 = x[..., :half], x[..., half:]
    return jnp.concatenate([x1 * c - x2 * s, x2 * c + x1 * s], axis=-1)


def _axial_rope(x, cos_r, sin_r, cos_c, sin_c):
    half = x.shape[-1] // 2
    return jnp.concatenate([_rotate_half(x[..., :half], cos_r, sin_r),
                            _rotate_half(x[..., half:], cos_c, sin_c)], axis=-1)


def _partial_rope(x, cos, sin):
    return jnp.concatenate([_rotate_half(x[..., :PARTIAL_ROPE_DIM], cos, sin),
                            x[..., PARTIAL_ROPE_DIM:]], axis=-1)


def _to_blocks(q):
    b, s = q.shape[:2]
    return jnp.moveaxis(q.reshape((b, s // Q_BLOCK, Q_BLOCK) + q.shape[2:]), 1, 0)


def _from_blocks(o):
    o = jnp.moveaxis(o, 0, 1)
    return o.reshape((o.shape[0], o.shape[1] * o.shape[2]) + o.shape[3:])


def _lambda_init(layer_idx):
    return 0.8 - 0.6 * math.exp(-0.3 * layer_idx)


def _mixer_gqa_axial(x, w_qkv, q_norm, k_norm, w_o, axial):
    b, s, _ = x.shape
    nq = A_HEADS * A_HEAD_DIM
    nkv = A_KV_HEADS * A_HEAD_DIM
    qkv = x @ w_qkv
    q = qkv[..., :nq].reshape(b, s, A_KV_HEADS, A_HEADS // A_KV_HEADS, A_HEAD_DIM)
    k = qkv[..., nq:nq + nkv].reshape(b, s, A_KV_HEADS, A_HEAD_DIM)
    v = qkv[..., nq + nkv:].reshape(b, s, A_KV_HEADS, A_HEAD_DIM)
    q = _axial_rope(_rmsnorm(q, q_norm), *axial)
    k = _axial_rope(_rmsnorm(k, k_norm), *axial)
    scale = A_HEAD_DIM ** -0.5

    def attend(qb):
        sc = jnp.einsum('bqkgd,bskd->bkgqs', qb, k).astype(jnp.float32) * scale
        p = jax.nn.softmax(sc, axis=-1).astype(v.dtype)
        return jnp.einsum('bkgqs,bskd->bqkgd', p, v)

    o = _from_blocks(lax.map(attend, _to_blocks(q)))
    return o.reshape(b, s, nq) @ w_o


def _mixer_fourier(x, w_o, b_o):
    b, s, d = x.shape
    u = x.astype(jnp.float32).reshape(b, s, FNET_GROUPS, d // FNET_GROUPS)
    f = jnp.fft.fft2(u, axes=(1, 3), norm='ortho').real
    return f.reshape(b, s, d).astype(x.dtype) @ w_o + b_o


def _mixer_diff(x, w_qkv, lq1, lk1, lq2, lk2, subln, w_o, rope, lambda_init):
    b, s, d = x.shape
    q, k, v = jnp.split(x @ w_qkv, 3, axis=-1)
    q = _partial_rope(q.reshape(b, s, C_HEADS, 2, C_HEAD_DIM), *rope)
    k = _partial_rope(k.reshape(b, s, C_HEADS, 2, C_HEAD_DIM), *rope)
    v = v.reshape(b, s, C_HEADS, 2 * C_HEAD_DIM)
    f32 = jnp.float32
    lam = (jnp.exp(jnp.sum(lq1.astype(f32) * lk1.astype(f32)))
           - jnp.exp(jnp.sum(lq2.astype(f32) * lk2.astype(f32))) + lambda_init)
    scale = C_HEAD_DIM ** -0.5

    def attend(qb):
        sc = jnp.einsum('bqhcd,bshcd->bhcqs', qb, k).astype(f32) * scale
        p = jax.nn.softmax(sc, axis=-1)
        a = (p[:, :, 0] - lam * p[:, :, 1]).astype(v.dtype)
        return jnp.einsum('bhqs,bshe->bqhe', a, v)

    o = _from_blocks(lax.map(attend, _to_blocks(q)))
    o = _rmsnorm(o, subln) * (1.0 - lambda_init)
    return o.reshape(b, s, d) @ w_o


def _conv_ffn(x, w_up, conv_w, conv_b, w_down):
    s = x.shape[1]
    h = x @ w_up
    pad = CONV_WIDTH // 2
    hp = jnp.pad(h, ((0, 0), (pad, pad), (0, 0)))
    h = conv_b + sum(hp[:, j:j + s] * conv_w[j] for j in range(CONV_WIDTH))
    gate, val = jnp.split(h, 2, axis=-1)
    return (jax.nn.silu(gate) * val) @ w_down


def _post_norm(x, sub, g, b):
    return _layernorm(DEEPNORM_ALPHA * x + sub, g, b)


def _dense(key, fan_in, fan_out, scale=1.0):
    return jax.random.normal(key, (fan_in, fan_out), jnp.float32) * (scale * fan_in ** -0.5)


def _gain(key, n):
    return 1.0 + 0.01 * jax.random.normal(key, (n,), jnp.float32)


def _bias(key, n):
    return 0.01 * jax.random.normal(key, (n,), jnp.float32)


def setup_inputs(seed: int = 0) -> dict:
    key = jax.random.key(seed)
    key, kx = jax.random.split(key)
    inputs = {'x': jax.random.normal(kx, (BATCH, SEQ, D_MODEL), jnp.float32)}
    qkv_a = (A_HEADS + 2 * A_KV_HEADS) * A_HEAD_DIM
    for i in range(DEPTH):
        ks = jax.random.split(jax.random.fold_in(key, i), 20)
        p = 'l%d_' % i
        kind = i % N_MIXERS
        if kind == 0:
            inputs[p + 'a_wqkv'] = _dense(ks[0], D_MODEL, qkv_a)
            inputs[p + 'a_qnorm'] = _gain(ks[1], A_HEAD_DIM)
            inputs[p + 'a_knorm'] = _gain(ks[2], A_HEAD_DIM)
            inputs[p + 'a_wo'] = _dense(ks[3], A_HEADS * A_HEAD_DIM, D_MODEL, DEEPNORM_BETA)
        elif kind == 1:
            inputs[p + 'f_wo'] = _dense(ks[0], D_MODEL, D_MODEL, DEEPNORM_BETA)
            inputs[p + 'f_bo'] = _bias(ks[1], D_MODEL)
        else:
            inputs[p + 'c_wqkv'] = _dense(ks[0], D_MODEL, 3 * D_MODEL)
            inputs[p + 'c_lq1'] = 0.1 * jax.random.normal(ks[1], (C_HEAD_DIM,), jnp.float32)
            inputs[p + 'c_lk1'] = 0.1 * jax.random.normal(ks[2], (C_HEAD_DIM,), jnp.float32)
            inputs[p + 'c_lq2'] = 0.1 * jax.random.normal(ks[3], (C_HEAD_DIM,), jnp.float32)
            inputs[p + 'c_lk2'] = 0.1 * jax.random.normal(ks[4], (C_HEAD_DIM,), jnp.float32)
            inputs[p + 'c_subln'] = _gain(ks[5], 2 * C_HEAD_DIM)
            inputs[p + 'c_wo'] = _dense(ks[6], D_MODEL, D_MODEL, DEEPNORM_BETA)
        inputs[p + 'ln1_g'] = _gain(ks[10], D_MODEL)
        inputs[p + 'ln1_b'] = _bias(ks[11], D_MODEL)
        inputs[p + 'ffn_wup'] = _dense(ks[12], D_MODEL, 2 * D_FF)
        inputs[p + 'ffn_conv_w'] = jax.random.normal(ks[13], (CONV_WIDTH, 2 * D_FF), jnp.float32) * CONV_WIDTH ** -0.5
        inputs[p + 'ffn_conv_b'] = _bias(ks[14], 2 * D_FF)
        inputs[p + 'ffn_wdown'] = _dense(ks[15], D_FF, D_MODEL, DEEPNORM_BETA)
        inputs[p + 'ln2_g'] = _gain(ks[16], D_MODEL)
        inputs[p + 'ln2_b'] = _bias(ks[17], D_MODEL)
    return inputs


def reference(x,
              l0_a_wqkv, l0_a_qnorm, l0_a_knorm, l0_a_wo,
              l0_ln1_g, l0_ln1_b, l0_ffn_wup, l0_ffn_conv_w, l0_ffn_conv_b, l0_ffn_wdown, l0_ln2_g, l0_ln2_b,
              l1_f_wo, l1_f_bo,
              l1_ln1_g, l1_ln1_b, l1_ffn_wup, l1_ffn_conv_w, l1_ffn_conv_b, l1_ffn_wdown, l1_ln2_g, l1_ln2_b,
              l2_c_wqkv, l2_c_lq1, l2_c_lk1, l2_c_lq2, l2_c_lk2, l2_c_subln, l2_c_wo,
              l2_ln1_g, l2_ln1_b, l2_ffn_wup, l2_ffn_conv_w, l2_ffn_conv_b, l2_ffn_wdown, l2_ln2_g, l2_ln2_b,
              l3_a_wqkv, l3_a_qnorm, l3_a_knorm, l3_a_wo,
              l3_ln1_g, l3_ln1_b, l3_ffn_wup, l3_ffn_conv_w, l3_ffn_conv_b, l3_ffn_wdown, l3_ln2_g, l3_ln2_b):
    s = x.shape[1]
    rows = s // GRID_W
    t_row = jnp.repeat(jnp.arange(rows, dtype=jnp.int32), GRID_W)
    t_col = jnp.tile(jnp.arange(GRID_W, dtype=jnp.int32), rows)
    axial = (_rope_cos_sin(t_row, A_HEAD_DIM // 2, AXIAL_THETA)
             + _rope_cos_sin(t_col, A_HEAD_DIM // 2, AXIAL_THETA))
    rope_c = _rope_cos_sin(jnp.arange(s, dtype=jnp.int32), PARTIAL_ROPE_DIM, ROPE_THETA)

    mixers = ((l0_a_wqkv, l0_a_qnorm, l0_a_knorm, l0_a_wo),
              (l1_f_wo, l1_f_bo),
              (l2_c_wqkv, l2_c_lq1, l2_c_lk1, l2_c_lq2, l2_c_lk2, l2_c_subln, l2_c_wo),
              (l3_a_wqkv, l3_a_qnorm, l3_a_knorm, l3_a_wo))
    norms1 = ((l0_ln1_g, l0_ln1_b), (l1_ln1_g, l1_ln1_b), (l2_ln1_g, l2_ln1_b), (l3_ln1_g, l3_ln1_b))
    ffns = ((l0_ffn_wup, l0_ffn_conv_w, l0_ffn_conv_b, l0_ffn_wdown),
            (l1_ffn_wup, l1_ffn_conv_w, l1_ffn_conv_b, l1_ffn_wdown),
            (l2_ffn_wup, l2_ffn_conv_w, l2_ffn_conv_b, l2_ffn_wdown),
            (l3_ffn_wup, l3_ffn_conv_w, l3_ffn_conv_b, l3_ffn_wdown))
    norms2 = ((l0_ln2_g, l0_ln2_b), (l1_ln2_g, l1_ln2_b), (l2_ln2_g, l2_ln2_b), (l3_ln2_g, l3_ln2_b))

    for i in range(DEPTH):
        kind = i % N_MIXERS
        if kind == 0:
            sub = _mixer_gqa_axial(x, *mixers[i], axial)
        elif kind == 1:
            sub = _mixer_fourier(x, *mixers[i])
        else:
            sub = _mixer_diff(x, *mixers[i], rope_c, _lambda_init(i))
        x = _post_norm(x, sub, *norms1[i])
        x = _post_norm(x, _conv_ffn(x, *ffns[i]), *norms2[i])
    return x
```

```cpp
#include <hip/hip_runtime.h>
#include <hip/hip_cooperative_groups.h>
#include <hip/hip_bf16.h>
#include <cstdio>
#include <cstdint>
#include <cmath>
namespace cg = cooperative_groups;

#define LAS __attribute__((address_space(3)))
#define GAS __attribute__((address_space(1)))
typedef unsigned short bf16_t;
typedef short bf16x8 __attribute__((ext_vector_type(8)));
typedef float f32x4 __attribute__((ext_vector_type(4)));
typedef float f32x2 __attribute__((ext_vector_type(2)));
typedef unsigned u32x4 __attribute__((ext_vector_type(4)));
typedef unsigned u32x2 __attribute__((ext_vector_type(2)));

constexpr int DM = 1024, NB = 8, SEQ = 4096, MROWS = NB * SEQ, DFF = 2816, NUP = 2 * DFF;
constexpr float LN_EPS = 1e-5f, RMS_EPS = 1e-6f;
constexpr float ALPHA = 1.681792830507429f;
constexpr float C2 = 0.125f * 1.4426950408889634f;
constexpr float LAMBDA_INIT2 = 0.47071301834358366f;

constexpr size_t MiB = 1u << 20;
constexpr size_t WS_WUP = 1 * MiB;
constexpr size_t WS_WDN = 45 * MiB;
constexpr size_t WS_QKV0 = 67 * MiB, WS_WO0 = 70 * MiB, WS_FWO = 72 * MiB, WS_QKV2 = 74 * MiB, WS_WO2 = 80 * MiB, WS_QKV3 = 82 * MiB, WS_WO3 = 85 * MiB;
constexpr size_t WS_TT = 87 * MiB;
constexpr size_t WS_AXC = 88 * MiB, WS_AXS = WS_AXC + 4096, WS_RC = WS_AXC + 65536, WS_RS = WS_RC + 131072;
constexpr size_t WS_XB = 90 * MiB;
constexpr size_t WS_R = 154 * MiB;
constexpr size_t WS_QKV = WS_R;
constexpr size_t WS_O_GQA = WS_R + 96 * MiB;
constexpr size_t WS_O12 = WS_R + 192 * MiB;
constexpr size_t WS_YT = WS_R + 64 * MiB;
constexpr size_t WS_XE = WS_R;
constexpr size_t WS_YCH = 88 * MiB + 512 * 1024;
constexpr size_t WS_A2 = WS_R + 294 * MiB;
constexpr size_t WS_G = WS_R;
constexpr size_t WS_E = WS_R + 176 * MiB;
constexpr size_t WS_XH7 = WS_R + 230 * MiB;
constexpr size_t WS_NEED = 512 * MiB;

constexpr int LDS_BYTES = 147456;

__device__ __forceinline__ float shx(float v, int lane, int m) { return __builtin_bit_cast(float, __builtin_amdgcn_ds_bpermute((lane ^ m) << 2, __builtin_bit_cast(int, v))); }
__device__ __forceinline__ float xsum16(float v) { auto r = __builtin_amdgcn_permlane16_swap(__float_as_uint(v), __float_as_uint(v), false, false); return __uint_as_float(r[0]) + __uint_as_float(r[1]); }
__device__ __forceinline__ float xsum32(float v) { auto r = __builtin_amdgcn_permlane32_swap(__float_as_uint(v), __float_as_uint(v), false, false); return __uint_as_float(r[0]) + __uint_as_float(r[1]); }
__device__ __forceinline__ float xpart16(float v, bool oddrow) { auto r = __builtin_amdgcn_permlane16_swap(__float_as_uint(v), __float_as_uint(v), false, false); return __uint_as_float(oddrow ? r[0] : r[1]); }
namespace pg8 {
constexpr int BM = 256, BK = 64, HALF = 128, HTB = HALF * BK * 2, NXCD = 8, WGM = 8;
__host__ __device__ __forceinline__ int lds_byte(int r, int c) { const int st = (r >> 4) * 2 + (c >> 5), rr = r & 15, cc = c & 31, ob = rr * 64 + cc * 2; return st * 1024 + (ob ^ (((ob >> 9) & 1) << 5)); }
__host__ __device__ __forceinline__ void stage_rc(int b, int& R, int& C) { const int st = b / 1024, sb = b % 1024, swz = sb ^ (((sb >> 9) & 1) << 5); R = (st >> 1) * 16 + swz / 64; C = (st & 1) * 32 + (swz % 64) / 2; }
__host__ __device__ __forceinline__ int perm32(int rho) { const int n = rho >> 4, i = rho & 15; return 8 * (i >> 2) + 4 * n + (i & 3); }

struct Unit { int pm, pn; };
struct StaticOrder {
    int nM, nN, nwg, G, c;
    __device__ void init(int nM_, int nN_, int G_, int c_) { nM = nM_; nN = nN_; nwg = nM * nN; G = G_; c = c_; }
    __device__ bool next(int i, Unit& u) const {
        const long L = (long)i * G + c; if (L >= nwg) return false;
        int wgid = (int)L; { const int q = nwg / NXCD, r = nwg % NXCD, xcd = wgid % NXCD, off = wgid / NXCD; wgid = (xcd < r ? xcd * (q + 1) : r * (q + 1) + (xcd - r) * q) + off; }
        const int nig = WGM * nN, gid = wgid / nig, fm = gid * WGM, gsz = (nM - fm) < WGM ? (nM - fm) : WGM;
        u.pm = fm + ((wgid % nig) % gsz); u.pn = (wgid % nig) / gsz; return true;
    }
};
__device__ __forceinline__ unsigned cvt_pk_f16(float lo, float hi) { unsigned r; asm volatile("v_cvt_pk_f16_f32 %0, %1, %2" : "=v"(r) : "v"(lo), "v"(hi)); return r; }
__device__ __forceinline__ unsigned cvt_pk_bf16(float lo, float hi) { unsigned r; asm volatile("v_cvt_pk_bf16_f32 %0, %1, %2" : "=v"(r) : "v"(lo), "v"(hi)); return r; }

struct MapStd { const char* A; const char* B; size_t lda2, ldb2;
    __device__ __forceinline__ void ptrs(const Unit& u, const char*& a, const char*& b) const { a = A + (size_t)u.pm * 256 * lda2; b = B + (size_t)u.pn * 256 * ldb2; } };
struct MapF1 { const char* Tt; const char* XE;
    __device__ __forceinline__ void ptrs(const Unit& u, const char*& a, const char*& b) const { a = Tt + (size_t)(u.pm & 1) * 256 * 512; b = XE + (size_t)(u.pm & 1) * (32u << 20) + (size_t)u.pn * 256 * 2048 + (size_t)(u.pm >> 1) * 512; } };
struct MapF2 { const char* A2; const char* YT;
    __device__ __forceinline__ void ptrs(const Unit& u, const char*& a, const char*& b) const { const size_t po = (size_t)((u.pm >> 3) & 1) * 4096;
        a = A2 + (size_t)(u.pm & 7) * 256 * 8192 + po; b = YT + (size_t)(u.pm >> 4) * (1024u * 8192u) + (size_t)u.pn * 256 * 8192 + po; } };

template <class T> __device__ __forceinline__ T gld(const GAS void* ub, unsigned boff) { return *(const GAS T*)((const GAS char*)ub + boff); }
template <class T> __device__ __forceinline__ void gst(GAS void* ub, unsigned boff, const T& v) { *(GAS T*)((GAS char*)ub + boff) = v; }
struct EpiResid { static constexpr bool PERM = false, APERM = false;
    const GAS float* X; GAS float* Y; const GAS float* bias;
    __device__ __forceinline__ void operator()(f32x4 (&acc)[2][2][4][2], const Unit& u, int wr, int wc, int lane) const {
        const int fr = lane & 15, fq = lane >> 4;
        const int colu = u.pn * BM + wc * 32;
        f32x4 bv[2][2];
#pragma unroll
        for (int bj = 0; bj < 2; ++bj)
#pragma unroll
            for (int n = 0; n < 2; ++n) bv[bj][n] = bias ? gld<f32x4>(bias + colu + bj * HALF + n * 16, 16u * fq) : (f32x4){0.f, 0.f, 0.f, 0.f};
#pragma unroll
        for (int ai = 0; ai < 2; ++ai) {
            const size_t uoff = (size_t)(u.pm * BM + ai * HALF + wr * 64) * DM + colu;
            const GAS float* xu = X + uoff; GAS float* yu = Y + uoff;
#pragma unroll
            for (int m = 0; m < 4; ++m) { const unsigned lo = (unsigned)((m * 16 + fr) * DM + 4 * fq) * 4u;
                f32x4 xv[2][2];
#pragma unroll
                for (int bj = 0; bj < 2; ++bj)
#pragma unroll
                    for (int n = 0; n < 2; ++n) xv[bj][n] = gld<f32x4>(xu + bj * HALF + n * 16, lo);
#pragma unroll
                for (int bj = 0; bj < 2; ++bj)
#pragma unroll
                    for (int n = 0; n < 2; ++n) gst<f32x4>(yu + bj * HALF + n * 16, lo, xv[bj][n] * ALPHA + acc[ai][bj][m][n] + bv[bj][n]);
                asm volatile("" ::: "memory"); }
        }
    }
};
struct PanelStats {
    unsigned* xbuf;
    unsigned* cnt;
    LAS unsigned char* tl;
    __device__ __forceinline__ void run(const f32x4 (&v)[2][2][4][2], const Unit& u, int wr, int wc, int lane) const {
        const int fr = lane & 15, fq = lane >> 4, wid = wr * 4 + wc;
        LAS f32x2* P = (LAS f32x2*)tl; LAS f32x2* S = (LAS f32x2*)(tl + 8192);
#pragma unroll
        for (int ai = 0; ai < 2; ++ai)
#pragma unroll
            for (int m = 0; m < 4; ++m) {
                float s = 0.f;
#pragma unroll
                for (int bj = 0; bj < 2; ++bj)
#pragma unroll
                    for (int n = 0; n < 2; ++n) { const f32x4 x = v[ai][bj][m][n]; s += (x[0] + x[1]) + (x[2] + x[3]); }
                s = xsum32(xsum16(s));
                const float mw = s * (1.0f / 64.0f); float q = 0.f;
#pragma unroll
                for (int bj = 0; bj < 2; ++bj)
#pragma unroll
                    for (int n = 0; n < 2; ++n) { const f32x4 d = v[ai][bj][m][n] - mw; q += (d[0] * d[0] + d[1] * d[1]) + (d[2] * d[2] + d[3] * d[3]); }
                q = xsum32(xsum16(q));
                if (fq == 0) P[(ai * HALF + wr * 64 + m * 16 + fr) * 4 + wc] = (f32x2){mw, q};
            }
        asm volatile("s_waitcnt lgkmcnt(0)" ::: "memory"); __builtin_amdgcn_s_barrier(); asm volatile("" ::: "memory");
        const int row = wid * 32 + (lane & 31);
        if (lane < 32) {
            const f32x2 a = P[row * 4 + 0], b = P[row * 4 + 1], c = P[row * 4 + 2], d = P[row * 4 + 3];
            const float mt = (a.x + b.x + c.x + d.x) * 0.25f;
            const float da = a.x - mt, db = b.x - mt, dc = c.x - mt, dd = d.x - mt;
            const float m2 = (a.y + b.y) + (c.y + d.y) + 64.0f * ((da * da + db * db) + (dc * dc + dd * dd));
            unsigned long long* slot = (unsigned long long*)xbuf + ((size_t)(u.pm * BM + row) * 4 + u.pn);
            __hip_atomic_store(slot, ((unsigned long long)__float_as_uint(m2) << 32) | __float_as_uint(mt), __ATOMIC_RELAXED, __HIP_MEMORY_SCOPE_AGENT);
        }
        asm volatile("s_waitcnt vmcnt(0)" ::: "memory");
        if (lane == 0) __hip_atomic_fetch_add(cnt + 64 * u.pm, 1u, __ATOMIC_RELAXED, __HIP_MEMORY_SCOPE_AGENT);
        if (wid == 0) {
            unsigned sp = 0;
            for (;;) {
                if ((unsigned)__builtin_amdgcn_readfirstlane(__hip_atomic_load(cnt + 64 * u.pm, __ATOMIC_RELAXED, __HIP_MEMORY_SCOPE_AGENT)) >= 32u) break;
                if (++sp > (1u << 24)) break;
                __builtin_amdgcn_s_sleep(2);
            }
            __builtin_amdgcn_fence(__ATOMIC_ACQUIRE, "agent");
        }
        asm volatile("s_waitcnt vmcnt(0) lgkmcnt(0)" ::: "memory"); __builtin_amdgcn_s_barrier(); asm volatile("" ::: "memory");
        if (lane < 32) {
            const unsigned long long* slot = (const unsigned long long*)xbuf + (size_t)(u.pm * BM + row) * 4; float mt[4], m2[4]; float ms = 0.f;
#pragma unroll
            for (int t = 0; t < 4; ++t) { const unsigned long long w = __hip_atomic_load(slot + t, __ATOMIC_RELAXED, __HIP_MEMORY_SCOPE_AGENT); mt[t] = __uint_as_float((unsigned)w); m2[t] = __uint_as_float((unsigned)(w >> 32)); ms += mt[t]; }
            const float mean = ms * 0.25f; float q = 0.f;
#pragma unroll
            for (int t = 0; t < 4; ++t) { const float dm = mt[t] - mean; q += m2[t] + 256.0f * dm * dm; }
            S[row] = (f32x2){mean, 1.0f / sqrtf(q * (1.0f / 1024.0f) + LN_EPS)};
        }
        asm volatile("s_waitcnt lgkmcnt(0)" ::: "memory"); __builtin_amdgcn_s_barrier(); asm volatile("" ::: "memory");
    }
};
struct EpiResidLn { static constexpr bool PERM = true, APERM = false;
    GAS float* Y; GAS bf16_t* XBo; const GAS bf16_t* XHr; GAS bf16_t* XHw; const GAS float* bias; const GAS float* g; const GAS float* b; PanelStats st; bool xbf;
    static __device__ __forceinline__ float h2f(unsigned short hbits) { return (float)__builtin_bit_cast(_Float16, hbits); }
    __device__ __forceinline__ void operator()(f32x4 (&acc)[2][2][4][2], const Unit& u, int wr, int wc, int lane) const {
        const int fr = lane & 15, fq = lane >> 4;
        const int colu = u.pn * BM + wc * 32;
        {
            f32x4 bv[2][2];
#pragma unroll
            for (int bj = 0; bj < 2; ++bj)
#pragma unroll
                for (int n = 0; n < 2; ++n) bv[bj][n] = bias ? gld<f32x4>(bias + colu + bj * HALF + n * 4, 32u * fq) : (f32x4){0.f, 0.f, 0.f, 0.f};
#pragma unroll
            for (int ai = 0; ai < 2; ++ai) {
                const GAS bf16_t* xu = XHr + (size_t)(u.pm * BM + ai * HALF + wr * 64) * DM + colu;
#pragma unroll
                for (int m = 0; m < 4; ++m) { const unsigned lo = (unsigned)((m * 16 + fr) * DM + 8 * fq) * 2u;
                    u32x4 xw[2];
#pragma unroll
                    for (int bj = 0; bj < 2; ++bj) xw[bj] = gld<u32x4>(xu + bj * HALF, lo);
#pragma unroll
                    for (int bj = 0; bj < 2; ++bj)
#pragma unroll
                        for (int n = 0; n < 2; ++n) { const unsigned w0 = xw[bj][2 * n], w1 = xw[bj][2 * n + 1];
                            const f32x4 xv = xbf ? (f32x4){__uint_as_float(w0 << 16), __uint_as_float(w0 & 0xffff0000u), __uint_as_float(w1 << 16), __uint_as_float(w1 & 0xffff0000u)}
                                                 : (f32x4){h2f((unsigned short)(w0 & 0xffffu)), h2f((unsigned short)(w0 >> 16)), h2f((unsigned short)(w1 & 0xffffu)), h2f((unsigned short)(w1 >> 16))};
                            acc[ai][bj][m][n] = xv * ALPHA + acc[ai][bj][m][n] + bv[bj][n]; }
                    asm volatile("" : "+v"(acc[ai][0][m][0]), "+v"(acc[ai][0][m][1]), "+v"(acc[ai][1][m][0]), "+v"(acc[ai][1][m][1]));
                    if (m & 1) asm volatile("" ::: "memory"); }
            }
        }
        st.run(acc, u, wr, wc, lane);
        const LAS f32x2* S = (const LAS f32x2*)(st.tl + 8192);
        f32x4 gv[2][2], bb[2][2];
#pragma unroll
        for (int bj = 0; bj < 2; ++bj)
#pragma unroll
            for (int n = 0; n < 2; ++n) { gv[bj][n] = gld<f32x4>(g + colu + bj * HALF + n * 4, 32u * fq); bb[bj][n] = gld<f32x4>(b + colu + bj * HALF + n * 4, 32u * fq); }
#pragma unroll
        for (int ai = 0; ai < 2; ++ai) {
            const size_t uoff = (size_t)(u.pm * BM + ai * HALF + wr * 64) * DM + colu;
            GAS float* yu = Y + uoff; GAS bf16_t* bu = XBo + uoff; GAS bf16_t* hu = XHw + uoff;
#pragma unroll
            for (int m = 0; m < 4; ++m) { const int r = ai * HALF + wr * 64 + m * 16 + fr; const f32x2 sr = S[r];
                const unsigned lo = (unsigned)((m * 16 + fr) * DM + 8 * fq);
#pragma unroll
                for (int bj = 0; bj < 2; ++bj) {
                    const f32x4 o0 = (acc[ai][bj][m][0] - sr.x) * sr.y * gv[bj][0] + bb[bj][0], o1 = (acc[ai][bj][m][1] - sr.x) * sr.y * gv[bj][1] + bb[bj][1];
                    if (Y) { gst<f32x4>(yu + bj * HALF, lo * 4u, o0); gst<f32x4>(yu + bj * HALF + 4, lo * 4u, o1); }
                    if (XHw) { u32x4 wh; wh.x = cvt_pk_f16(o0[0], o0[1]); wh.y = cvt_pk_f16(o0[2], o0[3]); wh.z = cvt_pk_f16(o1[0], o1[1]); wh.w = cvt_pk_f16(o1[2], o1[3]); gst<u32x4>(hu + bj * HALF, lo * 2u, wh); }
                    if (XBo) { u32x4 w; w.x = cvt_pk_bf16(o0[0], o0[1]); w.y = cvt_pk_bf16(o0[2], o0[3]); w.z = cvt_pk_bf16(o1[0], o1[1]); w.w = cvt_pk_bf16(o1[2], o1[3]); gst<u32x4>(bu + bj * HALF, lo * 2u, w); } }
            }
        }
    }
};
template <int MODE> struct EpiBf16 { static constexpr bool PERM = true, APERM = false;
    GAS bf16_t* O; float scale; const GAS float* corr;
    __device__ __forceinline__ void operator()(f32x4 (&acc)[2][2][4][2], const Unit& u, int wr, int wc, int lane) const {
        const int fr = lane & 15, fq = lane >> 4;
        size_t base; constexpr unsigned ldc = MODE == 0 ? DM : 4096;
        if (MODE == 0) { base = (size_t)(u.pm * BM) * DM + u.pn * BM; }
        else { const int g = u.pm >> 1, part = u.pm & 1, b = u.pn >> 3, st = u.pn & 7; base = ((size_t)b * 1024 + g * 256) * 4096 + (size_t)part * 2048 + st * 256; }
        GAS bf16_t* ou = O + base + (size_t)(wr * 64) * ldc + wc * 32;
        f32x4 cv[2][2];
#pragma unroll
        for (int bj = 0; bj < 2; ++bj)
#pragma unroll
            for (int n = 0; n < 2; ++n) { cv[bj][n] = (f32x4){0.f, 0.f, 0.f, 0.f};
                if (MODE == 0) { cv[bj][n] = gld<f32x4>(corr + (size_t)(u.pm >> 4) * 1024 + u.pn * BM + bj * HALF + wc * 32 + 4 * n, 32u * fq); if (fr & 1) cv[bj][n] = -cv[bj][n]; } }
#pragma unroll
        for (int ai = 0; ai < 2; ++ai)
#pragma unroll
            for (int m = 0; m < 4; ++m) { const unsigned lo = ((unsigned)(fr + ai * HALF + m * 16) * ldc + 8u * fq) * 2u;
#pragma unroll
                for (int bj = 0; bj < 2; ++bj) { const f32x4 v0 = (acc[ai][bj][m][0] + cv[bj][0]) * scale, v1 = (acc[ai][bj][m][1] + cv[bj][1]) * scale;
                    u32x4 w; w.x = cvt_pk_bf16(v0[0], v0[1]); w.y = cvt_pk_bf16(v0[2], v0[3]); w.z = cvt_pk_bf16(v1[0], v1[1]); w.w = cvt_pk_bf16(v1[2], v1[3]);
                    gst<u32x4>(ou + bj * HALF, lo, w); } }
    }
};
struct EpiF2s { static constexpr bool PERM = true, APERM = false;
    GAS bf16_t* Z; float scale; const GAS float* corr; GAS float* PS;
    __device__ __forceinline__ void operator()(f32x4 (&acc)[2][2][4][2], const Unit& u, int wr, int wc, int lane) const {
        const int fr = lane & 15, fq = lane >> 4;
        const int b = u.pm >> 4, part = (u.pm >> 3) & 1, kt = u.pm & 7;
        GAS float* ps = PS + (size_t)blockIdx.x * (32 * 512 * 4);
        const unsigned lops = (unsigned)((wr * 4 + wc) * 64 + lane) * 16u;
        if (part == 0) {
#pragma unroll
            for (int ai = 0; ai < 2; ++ai)
#pragma unroll
                for (int bj = 0; bj < 2; ++bj)
#pragma unroll
                    for (int m = 0; m < 4; ++m)
#pragma unroll
                        for (int n = 0; n < 2; ++n) gst<f32x4>(ps + (((ai * 2 + bj) * 4 + m) * 2 + n) * 2048, lops, acc[ai][bj][m][n]);
            return;
        }
        asm volatile("s_waitcnt vmcnt(0)" ::: "memory");
        f32x4 cv[2][2];
#pragma unroll
        for (int bj = 0; bj < 2; ++bj)
#pragma unroll
            for (int n = 0; n < 2; ++n) { cv[bj][n] = gld<f32x4>(corr + (size_t)b * 1024 + u.pn * BM + bj * HALF + wc * 32 + 4 * n, 32u * fq); if (fr & 1) cv[bj][n] = -cv[bj][n]; }
        GAS bf16_t* zu = Z + (size_t)b * SEQ * DM + u.pn * BM + wc * 32;
#pragma unroll
        for (int ai = 0; ai < 2; ++ai)
#pragma unroll
            for (int m = 0; m < 4; ++m) {
                const int k = kt * 256 + ai * HALF + wr * 64 + m * 16 + fr;
                const unsigned lo1 = ((unsigned)k * DM + 8u * fq) * 2u, lo2 = ((unsigned)(SEQ - k) * DM + 8u * fq) * 2u;
#pragma unroll
                for (int bj = 0; bj < 2; ++bj) {
                    const f32x4 c0 = gld<f32x4>(ps + (((ai * 2 + bj) * 4 + m) * 2 + 0) * 2048, lops) + cv[bj][0], c1 = gld<f32x4>(ps + (((ai * 2 + bj) * 4 + m) * 2 + 1) * 2048, lops) + cv[bj][1];
                    const f32x4 s0 = acc[ai][bj][m][0], s1 = acc[ai][bj][m][1];
                    const f32x4 p0 = (c0 + s0) * scale, p1 = (c1 + s1) * scale, q0 = (c0 - s0) * scale, q1 = (c1 - s1) * scale;
                    u32x4 w; w.x = cvt_pk_bf16(p0[0], p0[1]); w.y = cvt_pk_bf16(p0[2], p0[3]); w.z = cvt_pk_bf16(p1[0], p1[1]); w.w = cvt_pk_bf16(p1[2], p1[3]);
                    gst<u32x4>(zu + bj * HALF, lo1, w);
                    if (k != 0) { u32x4 v; v.x = cvt_pk_bf16(q0[0], q0[1]); v.y = cvt_pk_bf16(q0[2], q0[3]); v.z = cvt_pk_bf16(q1[0], q1[1]); v.w = cvt_pk_bf16(q1[2], q1[3]);
                        gst<u32x4>(zu + bj * HALF, lo2, v); }
                }
            }
    }
};
struct EpiQkvGqa { static constexpr bool PERM = true, APERM = false;
    GAS bf16_t* O; const GAS float* qg; const GAS float* kg; const GAS float* axc; const GAS float* axs;
    __device__ __forceinline__ void operator()(f32x4 (&acc)[2][2][4][2], const Unit& u, int wr, int wc, int lane) const {
        const int fr = lane & 15, fq = lane >> 4;
        const bool isv = u.pn == 5, isq = u.pn < 4;
        const GAS float* gp = isq ? qg : kg;
        const int dl = 32 * (fq >> 1) + 8 * (fq & 1);
        f32x4 gv[2][2];
#pragma unroll
        for (int bj = 0; bj < 2; ++bj)
#pragma unroll
            for (int n = 0; n < 2; ++n) gv[bj][n] = gld<f32x4>(gp + 16 * bj + 4 * n, 4u * dl);
        const float osc = isq ? C2 : 1.0f;
#pragma unroll
        for (int ai = 0; ai < 2; ++ai) {
            const int rowu = u.pm * BM + ai * HALF + wr * 64;
            GAS bf16_t* ou = O + (size_t)rowu * 1536 + u.pn * 256 + wc * 64;
#pragma unroll
            for (int m = 0; m < 4; ++m) {
                const unsigned lo = ((unsigned)(m * 16 + fr) * 1536u + (unsigned)dl) * 2u;
                f32x4 v[2][2];
#pragma unroll
                for (int bj = 0; bj < 2; ++bj)
#pragma unroll
                    for (int n = 0; n < 2; ++n) v[bj][n] = acc[ai][bj][m][n];
                if (!isv) {
                    float ss = 0.f;
#pragma unroll
                    for (int bj = 0; bj < 2; ++bj)
#pragma unroll
                        for (int n = 0; n < 2; ++n) ss += (v[bj][n][0] * v[bj][n][0] + v[bj][n][1] * v[bj][n][1]) + (v[bj][n][2] * v[bj][n][2] + v[bj][n][3] * v[bj][n][3]);
                    ss = xsum32(xsum16(ss));
                    const float rinv = 1.0f / sqrtf(ss * (1.0f / 64.0f) + RMS_EPS);
                    const int s = (rowu + m * 16 + fr) & (SEQ - 1);
                    const int t = (fq >> 1) == 0 ? (s >> 6) : (s & 63);
#pragma unroll
                    for (int n = 0; n < 2; ++n) {
                        const unsigned to = (unsigned)(t * 16 + 8 * (fq & 1) + 4 * n) * 4u;
                        const f32x4 c = gld<f32x4>(axc, to), sn = gld<f32x4>(axs, to);
                        const f32x4 x1 = v[0][n] * rinv * gv[0][n], x2 = v[1][n] * rinv * gv[1][n];
                        v[0][n] = (x1 * c - x2 * sn) * osc; v[1][n] = (x2 * c + x1 * sn) * osc;
                    }
                }
#pragma unroll
                for (int bj = 0; bj < 2; ++bj) { u32x4 w; w.x = cvt_pk_bf16(v[bj][0][0], v[bj][0][1]); w.y = cvt_pk_bf16(v[bj][0][2], v[bj][0][3]); w.z = cvt_pk_bf16(v[bj][1][0], v[bj][1][1]); w.w = cvt_pk_bf16(v[bj][1][2], v[bj][1][3]);
                    gst<u32x4>(ou + 16 * bj, lo, w); }
            }
        }
    }
};
struct EpiQkvDiff { static constexpr bool PERM = true, APERM = false;
    GAS bf16_t* O; const GAS float* rc; const GAS float* rs;
    __device__ __forceinline__ void operator()(f32x4 (&acc)[2][2][4][2], const Unit& u, int wr, int wc, int lane) const {
        const int fr = lane & 15, fq = lane >> 4;
        const bool ropesel = (u.pn < 8) && ((wc & 1) == 0);
        const bool rope = ropesel && (fq < 2);
        const float osc = (u.pn < 4) ? C2 : 1.0f;
#pragma unroll
        for (int ai = 0; ai < 2; ++ai) {
            const int rowu = u.pm * BM + ai * HALF + wr * 64;
            GAS bf16_t* ou = O + (size_t)rowu * 3072 + u.pn * BM + wc * 32;
#pragma unroll
            for (int m = 0; m < 4; ++m) {
                const unsigned lo = ((unsigned)(m * 16 + fr) * 3072u + 8u * fq) * 2u;
                const int s = (rowu + m * 16 + fr) & (SEQ - 1);
#pragma unroll
                for (int bj = 0; bj < 2; ++bj) {
                    f32x4 v0 = acc[ai][bj][m][0], v1 = acc[ai][bj][m][1];
                    if (ropesel) {
                        f32x4 p0, p1;
#pragma unroll
                        for (int j = 0; j < 4; ++j) { p0[j] = xpart16(v0[j], (fq & 1) != 0); p1[j] = xpart16(v1[j], (fq & 1) != 0); }
                        if (rope) {
                            const f32x4 ca = gld<f32x4>(rc, (unsigned)s * 32u), cb = gld<f32x4>(rc + 4, (unsigned)s * 32u), sa = gld<f32x4>(rs, (unsigned)s * 32u), sb = gld<f32x4>(rs + 4, (unsigned)s * 32u);
                            if (fq == 0) { v0 = v0 * ca - p0 * sa; v1 = v1 * cb - p1 * sb; }
                            else { v0 = v0 * ca + p0 * sa; v1 = v1 * cb + p1 * sb; }
                        }
                    }
                    v0 = v0 * osc; v1 = v1 * osc;
                    u32x4 w; w.x = cvt_pk_bf16(v0[0], v0[1]); w.y = cvt_pk_bf16(v0[2], v0[3]); w.z = cvt_pk_bf16(v1[0], v1[1]); w.w = cvt_pk_bf16(v1[2], v1[3]);
                    gst<u32x4>(ou + bj * HALF, lo, w);
                }
            }
        }
    }
};
__device__ __forceinline__ float dpp_ror1(float x) { return __builtin_bit_cast(float, __builtin_amdgcn_mov_dpp(__builtin_bit_cast(int, x), 0x121, 0xf, 0xf, true)); }
__device__ __forceinline__ float dpp_ror15(float x) { return __builtin_bit_cast(float, __builtin_amdgcn_mov_dpp(__builtin_bit_cast(int, x), 0x12F, 0xf, 0xf, true)); }
__device__ __forceinline__ float silu_mul(float g, float v) { return g * v * __builtin_amdgcn_rcpf(1.0f + __builtin_amdgcn_exp2f(-1.4426950408889634f * g)); }
struct EpiUpConv { static constexpr bool PERM = true, APERM = true;
    GAS bf16_t* G; GAS bf16_t* E; const GAS float* cw; const GAS float* cb;
    __device__ __forceinline__ void conv4(const f32x4& a0, const f32x4& a1, const f32x4& a2, const f32x4& a3, const f32x4& w0, const f32x4& w1, const f32x4& w2, const f32x4& b, f32x2 (&h)[4][2]) const {
#pragma unroll
        for (int p = 0; p < 2; ++p) {
            float u0, u1, d0, d1;
            asm volatile("s_nop 1\n\tv_mov_b32_dpp %0, %1 row_shr:1 row_mask:0xf bank_mask:0xf bound_ctrl:1" : "=&v"(u0) : "v"(a3[2 * p]));
            asm volatile("s_nop 1\n\tv_mov_b32_dpp %0, %1 row_shr:1 row_mask:0xf bank_mask:0xf bound_ctrl:1" : "=&v"(u1) : "v"(a3[2 * p + 1]));
            asm volatile("s_nop 1\n\tv_mov_b32_dpp %0, %1 row_shl:1 row_mask:0xf bank_mask:0xf bound_ctrl:1" : "=&v"(d0) : "v"(a0[2 * p]));
            asm volatile("s_nop 1\n\tv_mov_b32_dpp %0, %1 row_shl:1 row_mask:0xf bank_mask:0xf bound_ctrl:1" : "=&v"(d1) : "v"(a0[2 * p + 1]));
            const f32x2 UP = {u0, u1}, DN = {d0, d1};
            const f32x2 A0 = {a0[2 * p], a0[2 * p + 1]}, A1 = {a1[2 * p], a1[2 * p + 1]}, A2 = {a2[2 * p], a2[2 * p + 1]}, A3 = {a3[2 * p], a3[2 * p + 1]};
            const f32x2 W0 = {w0[2 * p], w0[2 * p + 1]}, W1 = {w1[2 * p], w1[2 * p + 1]}, W2 = {w2[2 * p], w2[2 * p + 1]}, B = {b[2 * p], b[2 * p + 1]};
            h[0][p] = B + W0 * UP + W1 * A0 + W2 * A1;
            h[1][p] = B + W0 * A0 + W1 * A1 + W2 * A2;
            h[2][p] = B + W0 * A1 + W1 * A2 + W2 * A3;
            h[3][p] = B + W0 * A2 + W1 * A3 + W2 * DN;
        }
    }
    static __device__ __forceinline__ unsigned silu_pk(const f32x2 g, const f32x2 v) {
        const f32x2 t = g * -1.4426950408889634f;
        const f32x2 d = (f32x2){__builtin_amdgcn_exp2f(t.x), __builtin_amdgcn_exp2f(t.y)} + 1.0f;
        const f32x2 o = g * v * (f32x2){__builtin_amdgcn_rcpf(d.x), __builtin_amdgcn_rcpf(d.y)};
        return cvt_pk_bf16(o.x, o.y);
    }
    __device__ __forceinline__ void operator()(f32x4 (&acc)[2][2][4][2], const Unit& u, int wr, int wc, int lane) const {
        const int fr = lane & 15, fq = lane >> 4;
        const int colu = u.pn * 128 + wc * 32;
        const GAS float* cwu = cw + colu; const GAS float* cbu = cb + colu;
        u32x2 keep[2][4];
        u32x2 ekeep[2][2][2];
        f32x4 wgt[2][8];
#pragma unroll
        for (int n = 0; n < 2; ++n) { const unsigned co = (unsigned)(8 * fq + 4 * n) * 4u;
            wgt[n][0] = gld<f32x4>(cwu, co); wgt[n][1] = gld<f32x4>(cwu + NUP, co); wgt[n][2] = gld<f32x4>(cwu + 2 * NUP, co); wgt[n][3] = gld<f32x4>(cbu, co);
            wgt[n][4] = gld<f32x4>(cwu + DFF, co); wgt[n][5] = gld<f32x4>(cwu + NUP + DFF, co); wgt[n][6] = gld<f32x4>(cwu + 2 * NUP + DFF, co); wgt[n][7] = gld<f32x4>(cbu + DFF, co); }
#pragma unroll
        for (int n = 0; n < 2; ++n) {
            const f32x4 wg0 = wgt[n][0], wg1 = wgt[n][1], wg2 = wgt[n][2], bg = wgt[n][3], wv0 = wgt[n][4], wv1 = wgt[n][5], wv2 = wgt[n][6], bvv = wgt[n][7];
#pragma unroll
            for (int ai = 0; ai < 2; ++ai) {
                const int blk = 4 * u.pm + 2 * ai + wr;
                GAS bf16_t* gu = G + (size_t)(u.pm * BM + ai * HALF + wr * 64) * DFF + colu;
                GAS bf16_t* eu = E + (size_t)blk * 4 * NUP + colu;
                f32x2 hg[4][2], hv[4][2];
                conv4(acc[ai][0][0][n], acc[ai][0][1][n], acc[ai][0][2][n], acc[ai][0][3][n], wg0, wg1, wg2, bg, hg);
                conv4(acc[ai][1][0][n], acc[ai][1][1][n], acc[ai][1][2][n], acc[ai][1][3][n], wv0, wv1, wv2, bvv, hv);
#pragma unroll
                for (int m = 0; m < 4; ++m) {
                    u32x2 w; w.x = silu_pk(hg[m][0], hv[m][0]); w.y = silu_pk(hg[m][1], hv[m][1]);
                    if (n == 0) keep[ai][m] = w;
                    else { u32x4 w4; w4.x = keep[ai][m].x; w4.y = keep[ai][m].y; w4.z = w.x; w4.w = w.y; gst<u32x4>(gu, ((unsigned)(4 * fr + m) * DFF + 8u * fq) * 2u, w4); }
                }
                if (fr == 0 || fr == 15) {
                    const int mb = fr == 0 ? 0 : 2;
#pragma unroll
                    for (int e = 0; e < 2; ++e) {
                        const f32x4 eg = fr == 0 ? acc[ai][0][e][n] : acc[ai][0][2 + e][n], ev = fr == 0 ? acc[ai][1][e][n] : acc[ai][1][2 + e][n];
                        const u32x2 pg = (u32x2){cvt_pk_f16(eg[0], eg[1]), cvt_pk_f16(eg[2], eg[3])}, pv = (u32x2){cvt_pk_f16(ev[0], ev[1]), cvt_pk_f16(ev[2], ev[3])};
                        if (n == 0) { ekeep[ai][e][0] = pg; ekeep[ai][e][1] = pv; }
                        else { const unsigned eo = ((unsigned)(mb + e) * NUP + 8u * fq) * 2u;
                            gst<u32x4>(eu, eo, (u32x4){ekeep[ai][e][0].x, ekeep[ai][e][0].y, pg.x, pg.y}); gst<u32x4>(eu + DFF, eo, (u32x4){ekeep[ai][e][1].x, ekeep[ai][e][1].y, pv.x, pv.y}); }
                    }
                }
            }
        }
    }
};

template <class Epi, class Map, bool ALIGN_EPI>
__device__ __forceinline__ void gemm_phase(const int tid, LAS unsigned char* lds, const int lda, const int ldb, const int K, const Map& MP, const StaticOrder& S, const Epi& E) {
    const int wid = __builtin_amdgcn_readfirstlane(tid >> 6), lane = tid & 63, wr = wid >> 2, wc = wid & 3, fr = lane & 15, fq = lane >> 4;
    const int nt = K / BK;
    unsigned voA, voB;
    { int R, C; stage_rc(tid * 16, R, C); const int Rb = Epi::PERM ? ((R & ~31) + perm32(R & 31)) : R;
      const int Ra = Epi::APERM ? ((R & ~63) + 4 * (R & 15) + ((R >> 4) & 3)) : R;
      voA = (unsigned)(Ra * lda + C) * 2u; voB = (unsigned)(Rb * ldb + C) * 2u; }
    const size_t r64A = (size_t)64 * lda * 2, r64B = (size_t)64 * ldb * 2;
    const size_t kstep = (size_t)(BK * 2);
    const size_t hstepA = (size_t)HALF * lda * 2, hstepB = (size_t)HALF * ldb * 2;
    const unsigned ldsw = (unsigned)wid * 1024u;
    const int aoff = lds_byte(wr * 64 + fr, fq * 8), boff = lds_byte(wc * 32 + fr, fq * 8);
#define PG8_SA(b, h) (((b) * 2 + (h)) * HTB)
#define PG8_SB(b, h) ((4 + (b) * 2 + (h)) * HTB)
#define PG8_STAGE(bufoff, gbase, voff) do { _Pragma("unroll") for (int _i = 0; _i < 2; ++_i) \
        __builtin_amdgcn_global_load_lds((const GAS unsigned*)((const GAS char*)(gbase) + (size_t)_i * r64##voff + (vo##voff)), (LAS unsigned*)(lds + (bufoff) + ldsw + _i * 8192), 16, 0, 0); } while (0)
#define PG8_LDA(dst, b, h) do { _Pragma("unroll") for (int m = 0; m < 4; ++m) _Pragma("unroll") for (int k = 0; k < 2; ++k) dst[m][k] = *(const LAS bf16x8*)(lds + PG8_SA(b, h) + aoff + m * 2048 + k * 1024); } while (0)
#define PG8_LDB(dst, b, h) do { _Pragma("unroll") for (int n = 0; n < 2; ++n) _Pragma("unroll") for (int k = 0; k < 2; ++k) dst[n][k] = *(const LAS bf16x8*)(lds + PG8_SB(b, h) + boff + n * 2048 + k * 1024); } while (0)
#define PG8_MMA(ai, bj, At, Bt) do { __builtin_amdgcn_s_setprio(1); _Pragma("unroll") for (int m = 0; m < 4; ++m) _Pragma("unroll") for (int n = 0; n < 2; ++n) _Pragma("unroll") for (int k = 0; k < 2; ++k) \
        acc[ai][bj][m][n] = __builtin_amdgcn_mfma_f32_16x16x32_bf16(Bt[n][k], At[m][k], acc[ai][bj][m][n], 0, 0, 0); __builtin_amdgcn_s_setprio(0); } while (0)
#define PG8_WAIT_V(n) asm volatile("s_waitcnt vmcnt(" #n ")" ::: "memory")
#define PG8_WAIT_L(n) asm volatile("s_waitcnt lgkmcnt(" #n ")" ::: "memory")
#define PG8_BAR __builtin_amdgcn_s_barrier()
#define PG8_SCHED __builtin_amdgcn_sched_barrier(0)
    Unit cur, nxt; int ui = 0;
    if (!S.next(0, cur)) return;
    f32x4 acc[2][2][4][2];
#pragma unroll
    for (int a = 0; a < 2; ++a)
#pragma unroll
        for (int b = 0; b < 2; ++b)
#pragma unroll
            for (int m = 0; m < 4; ++m)
#pragma unroll
                for (int n = 0; n < 2; ++n) acc[a][b][m][n] = (f32x4){0.f, 0.f, 0.f, 0.f};
    bf16x8 At[4][2], B0[2][2], B1[2][2];
    const char* cA; const char* cB; MP.ptrs(cur, cA, cB);
    PG8_STAGE(PG8_SB(0, 0), cB, B); PG8_STAGE(PG8_SB(0, 1), cB + hstepB, B); PG8_STAGE(PG8_SA(0, 0), cA, A); PG8_STAGE(PG8_SA(0, 1), cA + hstepA, A);
    if (wr == 1) PG8_BAR;
    PG8_WAIT_V(2); PG8_BAR;
    PG8_STAGE(PG8_SB(1, 0), cB + kstep, B); PG8_STAGE(PG8_SA(1, 0), cA + kstep, A); PG8_STAGE(PG8_SB(1, 1), cB + hstepB + kstep, B);
    PG8_WAIT_V(6); PG8_BAR;
    for (;;) {
        const bool has_next = S.next(ui + 1, nxt);
        const char* nA = cA; const char* nB = cB; if (has_next) MP.ptrs(nxt, nA, nB);
        for (int t = 0; t < nt; t += 2) {
            const bool last = (t == nt - 2);
            const char* a1 = cA + (size_t)(t + 1) * kstep;
            const char* a2 = last ? nA : cA + (size_t)(t + 2) * kstep; const char* b2 = last ? nB : cB + (size_t)(t + 2) * kstep;
            const char* a3 = a2 + kstep; const char* b3 = b2 + kstep;
            PG8_LDB(B0, 0, 0); PG8_LDB(B1, 0, 1); PG8_SCHED; PG8_LDA(At, 0, 0); PG8_STAGE(PG8_SA(1, 1), a1 + hstepA, A);
            PG8_WAIT_V(8); PG8_WAIT_L(0); PG8_BAR; PG8_MMA(0, 0, At, B0); PG8_MMA(0, 1, At, B1); PG8_BAR; PG8_SCHED;
            PG8_LDA(At, 0, 1); PG8_STAGE(PG8_SB(0, 0), b2, B); PG8_STAGE(PG8_SB(0, 1), b2 + hstepB, B); PG8_STAGE(PG8_SA(0, 0), a2, A);
            PG8_WAIT_V(8); PG8_WAIT_L(0); PG8_BAR; PG8_MMA(1, 0, At, B0); PG8_MMA(1, 1, At, B1); PG8_BAR; PG8_SCHED;
            PG8_LDB(B0, 1, 0); PG8_LDB(B1, 1, 1); PG8_SCHED; PG8_LDA(At, 1, 0); PG8_STAGE(PG8_SA(0, 1), a2 + hstepA, A);
            PG8_WAIT_V(8); PG8_WAIT_L(0); PG8_BAR; PG8_MMA(0, 0, At, B0); PG8_MMA(0, 1, At, B1); PG8_BAR; PG8_SCHED;
            PG8_LDA(At, 1, 1); PG8_STAGE(PG8_SB(1, 0), b3, B); PG8_STAGE(PG8_SB(1, 1), b3 + hstepB, B); PG8_STAGE(PG8_SA(1, 0), a3, A);
            PG8_WAIT_V(8); PG8_WAIT_L(0); PG8_BAR; PG8_MMA(1, 0, At, B0); PG8_MMA(1, 1, At, B1); PG8_BAR; PG8_SCHED;
        }
        if constexpr (ALIGN_EPI) { if (wr == 0) PG8_BAR; }
        { int ln_; asm volatile("v_mbcnt_lo_u32_b32 %0, -1, 0\n\tv_mbcnt_hi_u32_b32 %0, -1, %0" : "=v"(ln_)); E(acc, cur, wr, wc, ln_); }
        if (!has_next) break;
#pragma unroll
        for (int a = 0; a < 2; ++a)
#pragma unroll
            for (int b = 0; b < 2; ++b)
#pragma unroll
                for (int m = 0; m < 4; ++m)
#pragma unroll
                    for (int n = 0; n < 2; ++n) acc[a][b][m][n] = (f32x4){0.f, 0.f, 0.f, 0.f};
        cur = nxt; cA = nA; cB = nB; ++ui;
        if constexpr (ALIGN_EPI) { if (wr == 1) PG8_BAR; }
    }
    PG8_WAIT_V(0);
    if constexpr (!ALIGN_EPI) { if (wr == 0) PG8_BAR; }
    PG8_BAR;
#undef PG8_SA
#undef PG8_SB
#undef PG8_STAGE
#undef PG8_LDA
#undef PG8_LDB
#undef PG8_MMA
#undef PG8_WAIT_V
#undef PG8_WAIT_L
#undef PG8_BAR
#undef PG8_SCHED
}
}

namespace attn_body {
using bf16 = __hip_bfloat16;
using s16x4 = __attribute__((ext_vector_type(4))) short;
using f32x16 = __attribute__((ext_vector_type(16))) float;
constexpr int D = 64, NW = 8, QBLK = 32, QB = QBLK * NW, KVBLK = 64;
__device__ __forceinline__ int crow(int r, int hi) { return (r & 3) + 8 * (r >> 2) + 4 * hi; }
#define SBAR() __builtin_amdgcn_sched_barrier(0)
constexpr int NSLOT = 3, SLOTB = 8192;
constexpr int LDS_K = 0, LDS_V = NSLOT * SLOTB;
__device__ __forceinline__ void glds16(const void* ubase, unsigned voff, unsigned lds_dst) { unsigned keep;
  asm volatile("s_mov_b32 %0, m0\n\ts_mov_b32 m0, %3\n\ts_nop 0\n\tglobal_load_lds_dwordx4 %1, %2\n\ts_mov_b32 m0, %0" : "=&s"(keep) : "v"(voff), "s"(ubase), "s"(lds_dst) : "memory"); }
__device__ __forceinline__ float max3f(float a, float b, float c) { float r; asm("v_max3_f32 %0, %1, %2, %3" : "=v"(r) : "v"(a), "v"(b), "v"(c)); return r; }
__device__ __forceinline__ float max2f(float a, float b) { float r; asm("v_max_f32_e32 %0, %1, %2" : "=v"(r) : "v"(a), "v"(b)); return r; }
__device__ __forceinline__ float fadd_s(float a, float b) { float r; asm("v_add_f32_e32 %0, %1, %2" : "=v"(r) : "v"(a), "v"(b)); return r; }
__device__ __forceinline__ float fsub_s(float a, float b) { float r; asm("v_sub_f32_e32 %0, %1, %2" : "=v"(r) : "v"(a), "v"(b)); return r; }
typedef float f32x2_t __attribute__((ext_vector_type(2))); typedef __bf16 bf16x2_t __attribute__((ext_vector_type(2)));
__device__ __forceinline__ unsigned cvtpk_s(float lo, float hi) { f32x2_t v = {lo, hi}; bf16x2_t b = __builtin_convertvector(v, bf16x2_t); return __builtin_bit_cast(unsigned, b); }
#define WAIT_BAR(N) asm volatile("s_waitcnt vmcnt(" #N ") lgkmcnt(0)\n\ts_barrier" ::: "memory")

__device__ __forceinline__ void qkt(f32x16& p0, f32x16& p1, const char* Kslot, const bf16x8* qr, const f32x16& negm, int r32, int hi) {
  const char* kb = Kslot + hi * 1024 + r32 * 16;
  #pragma unroll
  for (int d0 = 0; d0 < 4; ++d0) {
    const bf16x8 b0 = *reinterpret_cast<const bf16x8*>(kb + d0 * 2048);
    const bf16x8 b1 = *reinterpret_cast<const bf16x8*>(kb + d0 * 2048 + 512);
    if (d0 == 0) { p0 = __builtin_amdgcn_mfma_f32_32x32x16_bf16(b0, qr[0], negm, 0, 0, 0); p1 = __builtin_amdgcn_mfma_f32_32x32x16_bf16(b1, qr[0], negm, 0, 0, 0); }
    else { p0 = __builtin_amdgcn_mfma_f32_32x32x16_bf16(b0, qr[d0], p0, 0, 0, 0); p1 = __builtin_amdgcn_mfma_f32_32x32x16_bf16(b1, qr[d0], p1, 0, 0, 0); } }
}
typedef __attribute__((address_space(3))) const char* lds_cptr;
typedef short v4i16_t __attribute__((ext_vector_type(4)));
__device__ __forceinline__ void kload8(bf16x8* kf, lds_cptr kp) {
  kf[0] = *(const __attribute__((address_space(3))) bf16x8*)(kp);        kf[1] = *(const __attribute__((address_space(3))) bf16x8*)(kp + 512);
  kf[2] = *(const __attribute__((address_space(3))) bf16x8*)(kp + 2048); kf[3] = *(const __attribute__((address_space(3))) bf16x8*)(kp + 2560);
  kf[4] = *(const __attribute__((address_space(3))) bf16x8*)(kp + 4096); kf[5] = *(const __attribute__((address_space(3))) bf16x8*)(kp + 4608);
  kf[6] = *(const __attribute__((address_space(3))) bf16x8*)(kp + 6144); kf[7] = *(const __attribute__((address_space(3))) bf16x8*)(kp + 6656);
}
__device__ __forceinline__ void kload2(bf16x8* kf, lds_cptr kp, int j) { kf[2 * j] = *(const __attribute__((address_space(3))) bf16x8*)(kp + j * 2048); kf[2 * j + 1] = *(const __attribute__((address_space(3))) bf16x8*)(kp + j * 2048 + 512); }
__device__ __forceinline__ s16x4 vtr(lds_cptr p) { return __builtin_bit_cast(s16x4, __builtin_amdgcn_ds_read_tr16_b64_v4i16((__attribute__((address_space(3))) v4i16_t*)p)); }
__device__ __forceinline__ float rowmax(const f32x16& p0, const f32x16& p1) {
  float a = max3f(p0[0], p0[1], p1[0]), b = max3f(p0[2], p0[3], p1[1]); a = max3f(a, p1[2], p1[3]);
  #pragma unroll
  for (int r = 4; r < 16; r += 4) { a = max3f(a, p0[r], p0[r + 1]); b = max3f(b, p0[r + 2], p0[r + 3]); a = max3f(a, p1[r], p1[r + 1]); b = max3f(b, p1[r + 2], p1[r + 3]); }
  const float m = max2f(a, b);
  auto rr = __builtin_amdgcn_permlane32_swap(__float_as_uint(m), __float_as_uint(m), false, false);
  return max2f(__uint_as_float(rr[0]), __uint_as_float(rr[1]));
}
__device__ __forceinline__ void pv(f32x16* o, int vb, bf16x8 pa0, bf16x8 pa1, bf16x8 pa2, bf16x8 pa3) {
  #pragma unroll
  for (int d0 = 0; d0 < 2; ++d0) { s16x4 lo[4], hi[4];
    #pragma unroll
    for (int ks = 0; ks < 4; ++ks) {
      asm volatile("ds_read_b64_tr_b16 %0,%1 offset:%c2" : "=&v"(lo[ks]) : "v"(vb), "i"(d0 * 4096 + ks * 1024) : "memory");
      asm volatile("ds_read_b64_tr_b16 %0,%1 offset:%c2" : "=&v"(hi[ks]) : "v"(vb), "i"(d0 * 4096 + ks * 1024 + 512) : "memory"); }
    asm volatile("s_waitcnt lgkmcnt(0)" ::: "memory"); SBAR();
    #define PK(k) (bf16x8){lo[k][0], lo[k][1], lo[k][2], lo[k][3], hi[k][0], hi[k][1], hi[k][2], hi[k][3]}
    o[d0] = __builtin_amdgcn_mfma_f32_32x32x16_bf16(pa0, PK(0), o[d0], 0, 0, 0);
    o[d0] = __builtin_amdgcn_mfma_f32_32x32x16_bf16(pa1, PK(1), o[d0], 0, 0, 0);
    o[d0] = __builtin_amdgcn_mfma_f32_32x32x16_bf16(pa2, PK(2), o[d0], 0, 0, 0);
    o[d0] = __builtin_amdgcn_mfma_f32_32x32x16_bf16(pa3, PK(3), o[d0], 0, 0, 0);
    #undef PK
  }
}
template <int THRL, int KP, int DV2, bool NOMAX = false> __device__ __forceinline__ void attn_unit(int q0, const bf16* Qh, const bf16* __restrict__ Kh, const bf16* __restrict__ Vh, bf16* Oh, char* shm, const int tid, const bool comb = false, const float lam = 0.f, const float* subln = nullptr) {
  constexpr int OP = 1024, NT = 64;
  constexpr int LDS_WS = LDS_V + DV2 * NSLOT * SLOTB, LDS_OST = LDS_WS + NW * 64 * 4;
  const int lane = tid & 63, r32 = lane & 31, hi = lane >> 5; const int wid = __builtin_amdgcn_readfirstlane(tid >> 6);
  const bf16* Qw = Qh + (long)(q0 + wid * QBLK) * KP;
  const unsigned lds0 = (unsigned)(uintptr_t)shm;
  float* wsf = (float*)(shm + LDS_WS) + wid * 64;
  const bf16* ksrc = Kh + wid * 8; const unsigned kvo = (unsigned)(lane * KP) * 2u;
  const bf16* vsrc = Vh + (long)(16 * (wid & 3)) * KP + (wid >> 2) * 32; const unsigned vvo = (unsigned)((lane >> 2) * KP + (lane & 3) * 8) * 2u;
  const unsigned kdst = lds0 + LDS_K + wid * 1024, vdst = lds0 + LDS_V + wid * 1024;
  #define DMA_K(t, slot) glds16(ksrc + (long)(t) * KVBLK * KP, kvo, (unsigned)__builtin_amdgcn_readfirstlane(kdst + (slot)))
  #define DMA_V(t, slot) do { glds16(vsrc + (long)(t) * KVBLK * KP, vvo, (unsigned)__builtin_amdgcn_readfirstlane(vdst + DV2 * (slot))); \
    if constexpr (DV2 == 2) glds16(vsrc + 64 + (long)(t) * KVBLK * KP, vvo, (unsigned)__builtin_amdgcn_readfirstlane(vdst + DV2 * (slot) + 8192)); } while (0)
  const int vb0 = (int)(lds0 + LDS_V) + ((lane >> 4) & 1) * 32 + (lane & 3) * 8 + (4 * hi + ((lane & 15) >> 2)) * 64;
  const char* Kbase = shm + LDS_K; bf16x8 kf[8];
  const lds_cptr shm3 = (lds_cptr)shm; const lds_cptr kp0 = shm3 + LDS_K + hi * 1024 + r32 * 16; const lds_cptr vp0 = shm3 + LDS_V + ((lane >> 4) & 1) * 32 + (lane & 3) * 8 + (4 * hi + ((lane & 15) >> 2)) * 64;
  DMA_K(0, 0); DMA_V(0, 0); DMA_K(1, SLOTB);
  bf16x8 qr[4];
  #pragma unroll
  for (int d0 = 0; d0 < 4; ++d0) qr[d0] = *reinterpret_cast<const bf16x8*>(&Qw[(long)r32 * KP + d0 * 16 + hi * 8]);
  float z0 = 0.f; asm volatile("" : "+v"(z0)); float mhat = z0, l_reg = z0; f32x16 o[2 * DV2], negm;
  _Pragma("unroll") for (int r = 0; r < 16; ++r) { _Pragma("unroll") for (int d_ = 0; d_ < 2 * DV2; ++d_) o[d_][r] = z0; negm[r] = z0; } asm volatile("" : "+v"(negm));
  bool resc = false;
  #define START(P0, P1) do { resc = false; \
    if constexpr (!NOMAX) { const float rm = rowmax(P0, P1); const float dl = rm; mhat = fadd_s(mhat, dl); \
      _Pragma("unroll") for (int r = 0; r < 16; ++r) { P0[r] = fsub_s(P0[r], dl); P1[r] = fsub_s(P1[r], dl); } \
      _Pragma("unroll") for (int r = 0; r < 16; ++r) negm[r] = -mhat; asm volatile("" : "+v"(negm)); } \
    _Pragma("unroll") for (int r = 0; r < 16; ++r) P0[r] = __builtin_amdgcn_exp2f(P0[r]); } while (0)
  #define RESC() do { if constexpr (!NOMAX) if (resc) { asm volatile("s_waitcnt lgkmcnt(0)" ::: "memory"); \
      _Pragma("unroll") for (int d_ = 0; d_ < 2 * DV2; ++d_) _Pragma("unroll") for (int r = 0; r < 16; ++r) o[d_][r] *= wsf[crow(r, hi)]; } } while (0)
  f32x16 pA0, pA1, pB0, pB1;
  int sl_prev = 0, sl_cur = 0, sl_next = SLOTB;
  #define ROT() do { sl_prev = sl_cur; sl_cur = sl_next; sl_next = (sl_next == (NSLOT - 1) * SLOTB) ? 0 : sl_next + SLOTB; } while (0)
  DMA_K(2, 2 * SLOTB);
  if constexpr (DV2 == 2) { WAIT_BAR(4); } else { WAIT_BAR(3); }
  qkt(pA0, pA1, Kbase, qr, negm, r32, hi); asm volatile("s_nop 15\n\ts_nop 7" : "+v"(pA0), "+v"(pA1));
  START(pA0, pA1);
  _Pragma("unroll") for (int r = 0; r < 16; ++r) pA1[r] = __builtin_amdgcn_exp2f(pA1[r]);
  WAIT_BAR(0);
  DMA_K(3, 0); DMA_V(1, SLOTB);
  ROT();
  kload8(kf, kp0 + sl_cur);
  if constexpr (DV2 == 2) { WAIT_BAR(3); } else { WAIT_BAR(2); }
  s16x4 vlo[8], vhi[8]; u32x4 pw0, pw1, pw2, pw3;
  #define PKW(P, B) cvtpk_s(P[B], P[B + 1])
  #define PAF(k) __builtin_bit_cast(bf16x8, pw##k)
  #define VFR(i) (bf16x8){vlo[i][0], vlo[i][1], vlo[i][2], vlo[i][3], vhi[i][0], vhi[i][1], vhi[i][2], vhi[i][3]}
  #define PIN(x) asm volatile("" : "+v"(x))
  #define MX3(a, b, c) __builtin_fmaxf(__builtin_fmaxf((a), (b)), (c))
  #define GAPA(MF, A0, A1, A2, A3, W0, W1, PW) do { MF; sacc += A0; sacc += A1; sacc += A2; sacc += A3; PIN(sacc); W0; W1; PIN(PW); SBAR(); } while (0)
  #define EX(v) __builtin_amdgcn_exp2f(v)
  #define GAPB(MF, X, B) do { MF; X[B] = EX(X[B]); X[B + 1] = EX(X[B + 1]); X[B + 2] = EX(X[B + 2]); X[B + 3] = EX(X[B + 3]); PIN(X); SBAR(); } while (0)
  #define VRD(i) do { vlo[i] = vtr(vp_ + (((i) >> 2) * 4096 + ((i) & 3) * 1024)); vhi[i] = vtr(vp_ + (((i) >> 2) * 4096 + ((i) & 3) * 1024 + 512)); } while (0)
  #define VRD2(i) do { if constexpr (DV2 == 2) { vlo[i] = vtr(vp_ + (8192 + ((i) >> 2) * 4096 + ((i) & 3) * 1024)); vhi[i] = vtr(vp_ + (8192 + ((i) >> 2) * 4096 + ((i) & 3) * 1024 + 512)); SBAR(); } } while (0)
  #define KRD(G, j) do { if (G) { kload2(kf, kp0 + sl_next, j); SBAR(); } } while (0)
  #define STEP(C0, C1, P0, P1, t, GK, GV, GL) do { SBAR(); \
    const lds_cptr vp_ = vp0 + DV2 * sl_prev; \
    VRD(0); SBAR(); float sacc = (P0[0] + P0[1]); \
    GAPA(C0 = __builtin_amdgcn_mfma_f32_32x32x16_bf16(kf[0], qr[0], negm, 0, 0, 0), P0[2], P0[3], P0[4], P0[5],     pw0[0] = PKW(P0, 0), pw0[1] = PKW(P0, 2), pw0); \
    VRD(4); SBAR(); GAPA(C1 = __builtin_amdgcn_mfma_f32_32x32x16_bf16(kf[1], qr[0], negm, 0, 0, 0), P0[6], P0[7], P0[8], P0[9],     pw0[2] = PKW(P0, 4), pw0[3] = PKW(P0, 6), pw0); \
    VRD(1); SBAR(); GAPA(C0 = __builtin_amdgcn_mfma_f32_32x32x16_bf16(kf[2], qr[1], C0, 0, 0, 0),   P0[10], P0[11], P0[12], P0[13], pw1[0] = PKW(P0, 8), pw1[1] = PKW(P0, 10), pw1); \
    VRD(5); SBAR(); GAPA(C1 = __builtin_amdgcn_mfma_f32_32x32x16_bf16(kf[3], qr[1], C1, 0, 0, 0),   P0[14], P0[15], P1[0], P1[1],   pw1[2] = PKW(P0, 12), pw1[3] = PKW(P0, 14), pw1); \
    VRD(2); SBAR(); GAPA(C0 = __builtin_amdgcn_mfma_f32_32x32x16_bf16(kf[4], qr[2], C0, 0, 0, 0),   P1[2], P1[3], P1[4], P1[5],     pw2[0] = PKW(P1, 0), pw2[1] = PKW(P1, 2), pw2); \
    VRD(6); SBAR(); GAPA(C1 = __builtin_amdgcn_mfma_f32_32x32x16_bf16(kf[5], qr[2], C1, 0, 0, 0),   P1[6], P1[7], P1[8], P1[9],     pw2[2] = PKW(P1, 4), pw2[3] = PKW(P1, 6), pw2); \
    VRD(3); SBAR(); GAPA(C0 = __builtin_amdgcn_mfma_f32_32x32x16_bf16(kf[6], qr[3], C0, 0, 0, 0),   P1[10], P1[11], P1[12], P1[13], pw3[0] = PKW(P1, 8), pw3[1] = PKW(P1, 10), pw3); \
    VRD(7); SBAR(); GAPA(C1 = __builtin_amdgcn_mfma_f32_32x32x16_bf16(kf[7], qr[3], C1, 0, 0, 0),   P1[14], P1[15], 0.f, 0.f,       pw3[2] = PKW(P1, 12), pw3[3] = PKW(P1, 14), pw3); \
    l_reg += sacc; \
    if (GK) { DMA_K((t) + 3, sl_cur); } if (GV) { DMA_V((t) + 1, sl_next); } \
    if constexpr (!NOMAX) { float a = MX3(C0[0], C0[1], C1[0]), b = MX3(C0[2], C0[3], C1[1]); a = MX3(a, C1[2], C1[3]); \
      _Pragma("unroll") for (int r = 4; r < 16; r += 4) { a = MX3(a, C0[r], C0[r + 1]); b = MX3(b, C0[r + 2], C0[r + 3]); a = MX3(a, C1[r], C1[r + 1]); b = MX3(b, C1[r + 2], C1[r + 3]); } \
      float rm = __builtin_fmaxf(a, b); { auto rr = __builtin_amdgcn_permlane32_swap(__float_as_uint(rm), __float_as_uint(rm), false, false); rm = __builtin_fmaxf(__uint_as_float(rr[0]), __uint_as_float(rr[1])); } \
      resc = false; \
      if (__builtin_expect(__any(rm > (float)THRL), 0)) { const float dl = __builtin_fmaxf(rm, 0.f); mhat += dl; \
        _Pragma("unroll") for (int r = 0; r < 16; ++r) { C0[r] -= dl; C1[r] -= dl; } \
        _Pragma("unroll") for (int r = 0; r < 16; ++r) negm[r] = -mhat; asm volatile("" : "+v"(negm)); \
        const float f = __builtin_amdgcn_exp2f(-dl); l_reg *= f; if (hi == 0) wsf[r32] = f; resc = true; } } \
    SBAR(); \
    GAPB(o[0] = __builtin_amdgcn_mfma_f32_32x32x16_bf16(PAF(0), VFR(0), o[0], 0, 0, 0), C0, 0); VRD2(0); \
    GAPB(o[1] = __builtin_amdgcn_mfma_f32_32x32x16_bf16(PAF(0), VFR(4), o[1], 0, 0, 0), C0, 4); VRD2(4); \
    KRD(GL, 0); GAPB(o[0] = __builtin_amdgcn_mfma_f32_32x32x16_bf16(PAF(1), VFR(1), o[0], 0, 0, 0), C0, 8); VRD2(1); \
    KRD(GL, 1); GAPB(o[1] = __builtin_amdgcn_mfma_f32_32x32x16_bf16(PAF(1), VFR(5), o[1], 0, 0, 0), C0, 12); VRD2(5); \
    KRD(GL, 2); GAPB(o[0] = __builtin_amdgcn_mfma_f32_32x32x16_bf16(PAF(2), VFR(2), o[0], 0, 0, 0), C1, 0); VRD2(2); \
    KRD(GL, 3); GAPB(o[1] = __builtin_amdgcn_mfma_f32_32x32x16_bf16(PAF(2), VFR(6), o[1], 0, 0, 0), C1, 4); VRD2(6); \
    GAPB(o[0] = __builtin_amdgcn_mfma_f32_32x32x16_bf16(PAF(3), VFR(3), o[0], 0, 0, 0), C1, 8); VRD2(3); \
    GAPB(o[1] = __builtin_amdgcn_mfma_f32_32x32x16_bf16(PAF(3), VFR(7), o[1], 0, 0, 0), C1, 12); VRD2(7); \
    if constexpr (DV2 == 2) { \
      o[2] = __builtin_amdgcn_mfma_f32_32x32x16_bf16(PAF(0), VFR(0), o[2], 0, 0, 0); o[3] = __builtin_amdgcn_mfma_f32_32x32x16_bf16(PAF(0), VFR(4), o[3], 0, 0, 0); \
      o[2] = __builtin_amdgcn_mfma_f32_32x32x16_bf16(PAF(1), VFR(1), o[2], 0, 0, 0); o[3] = __builtin_amdgcn_mfma_f32_32x32x16_bf16(PAF(1), VFR(5), o[3], 0, 0, 0); \
      o[2] = __builtin_amdgcn_mfma_f32_32x32x16_bf16(PAF(2), VFR(2), o[2], 0, 0, 0); o[3] = __builtin_amdgcn_mfma_f32_32x32x16_bf16(PAF(2), VFR(6), o[3], 0, 0, 0); \
      o[2] = __builtin_amdgcn_mfma_f32_32x32x16_bf16(PAF(3), VFR(3), o[2], 0, 0, 0); o[3] = __builtin_amdgcn_mfma_f32_32x32x16_bf16(PAF(3), VFR(7), o[3], 0, 0, 0); SBAR(); } \
    } while (0)
  int t = 1;
  for (; t + 5 < NT; t += 2) {
    STEP(pB0, pB1, pA0, pA1, t, true, true, true);     if constexpr (DV2 == 2) { WAIT_BAR(3); } else { WAIT_BAR(2); } RESC(); ROT();
    STEP(pA0, pA1, pB0, pB1, t + 1, true, true, true); if constexpr (DV2 == 2) { WAIT_BAR(3); } else { WAIT_BAR(2); } RESC(); ROT();
  }
  #define ENDW(tt) do { if constexpr (DV2 == 2) { if ((tt) + 3 < NT) { WAIT_BAR(3); } else if ((tt) + 2 < NT) { WAIT_BAR(2); } else { WAIT_BAR(0); } } \
    else { if ((tt) + 3 < NT) { WAIT_BAR(2); } else if ((tt) + 2 < NT) { WAIT_BAR(1); } else { WAIT_BAR(0); } } } while (0)
  for (; t + 1 < NT; t += 2) {
    STEP(pB0, pB1, pA0, pA1, t, (t + 3 < NT), (t + 1 < NT), (t + 1 < NT));         ENDW(t);     RESC(); ROT();
    STEP(pA0, pA1, pB0, pB1, t + 1, (t + 4 < NT), (t + 2 < NT), (t + 2 < NT));     ENDW(t + 1); RESC(); ROT();
  }
  STEP(pB0, pB1, pA0, pA1, NT - 1, false, false, false); RESC();
  { float sacc = pB0[0] + pB0[1]; _Pragma("unroll") for (int r = 2; r < 16; ++r) sacc += pB0[r]; _Pragma("unroll") for (int r = 0; r < 16; ++r) sacc += pB1[r]; l_reg += sacc;
    pw0 = (u32x4){PKW(pB0, 0), PKW(pB0, 2), PKW(pB0, 4), PKW(pB0, 6)}; pw1 = (u32x4){PKW(pB0, 8), PKW(pB0, 10), PKW(pB0, 12), PKW(pB0, 14)}; pw2 = (u32x4){PKW(pB1, 0), PKW(pB1, 2), PKW(pB1, 4), PKW(pB1, 6)}; pw3 = (u32x4){PKW(pB1, 8), PKW(pB1, 10), PKW(pB1, 12), PKW(pB1, 14)};
    SBAR(); pv(o, vb0 + DV2 * sl_cur, PAF(0), PAF(1), PAF(2), PAF(3)); if constexpr (DV2 == 2) pv(o + 2, vb0 + DV2 * sl_cur + 8192, PAF(0), PAF(1), PAF(2), PAF(3)); }
  #undef PKW
  #undef PAF
  #undef VFR
  #undef PIN
  #undef MX3
  #undef GAPA
  #undef GAPB
  #undef EX
  #undef VRD
  #undef KRD
  #undef VRD2
  #undef STEP
  #undef ENDW
  { auto rr = __builtin_amdgcn_permlane32_swap(__float_as_uint(l_reg), __float_as_uint(l_reg), false, false); l_reg = __uint_as_float(rr[0]) + __uint_as_float(rr[1]); }
  int lane_e; asm volatile("v_mbcnt_lo_u32_b32 %0, -1, 0\n\tv_mbcnt_hi_u32_b32 %0, -1, %0" : "=v"(lane_e));
  const int r32e = lane_e & 31, hie = lane_e >> 5;
  if (hie == 0) wsf[32 + r32e] = l_reg; asm volatile("s_waitcnt lgkmcnt(0)" ::: "memory");
  float rli[16];
  #pragma unroll
  for (int r = 0; r < 16; ++r) rli[r] = __builtin_amdgcn_rcpf(wsf[32 + crow(r, hie)]);
  bf16* Ow = Oh + (long)(q0 + wid * QBLK) * OP;
  { bf16* stg = (bf16*)(shm + LDS_OST) + wid * 2048;
    if (DV2 == 2 && comb) {
      asm volatile("s_waitcnt vmcnt(0)" ::: "memory");
      u32x4 w1a[2][4];
      #pragma unroll
      for (int hv = 0; hv < DV2; ++hv)
        #pragma unroll
        for (int i = 0; i < 4; ++i) { const int row = i * 8 + (lane_e >> 3), ch = lane_e & 7; w1a[hv][i] = *(const u32x4*)(Ow + (long)row * OP + hv * 64 + ch * 8); }
      float dd[2][4][8]; float ss[4] = {0.f, 0.f, 0.f, 0.f};
      #pragma unroll
      for (int hv = 0; hv < DV2; ++hv) {
        #pragma unroll
        for (int r = 0; r < 16; ++r) { const int orow = crow(r, hie);
          #pragma unroll
          for (int d0 = 0; d0 < 2; ++d0) stg[orow * 64 + d0 * 32 + r32e] = __float2bfloat16(o[2 * hv + d0][r] * rli[r]); }
        asm volatile("s_waitcnt lgkmcnt(0)" ::: "memory");
        #pragma unroll
        for (int i = 0; i < 4; ++i) { const int row = i * 8 + (lane_e >> 3), ch = lane_e & 7; const u32x4 v = *(const u32x4*)(stg + row * 64 + ch * 8);
          const u32x4 w1 = w1a[hv][i];
          #pragma unroll
          for (int j = 0; j < 4; ++j) { const float a0 = __uint_as_float(w1[j] << 16), a1 = __uint_as_float(w1[j] & 0xffff0000u), b0 = __uint_as_float(v[j] << 16), b1 = __uint_as_float(v[j] & 0xffff0000u);
            const float e0 = a0 - lam * b0, e1 = a1 - lam * b1; dd[hv][i][2 * j] = e0; dd[hv][i][2 * j + 1] = e1; ss[i] += e0 * e0 + e1 * e1; } }
        asm volatile("s_waitcnt lgkmcnt(0)" ::: "memory"); }
      #pragma unroll
      for (int i = 0; i < 4; ++i) {
        float t = ss[i];
        #pragma unroll
        for (int m_ = 1; m_ < 8; m_ <<= 1) t += __builtin_bit_cast(float, __builtin_amdgcn_ds_bpermute((lane_e ^ m_) << 2, __builtin_bit_cast(int, t)));
        const float rinv = (1.0f - 0.47071301834358366f) / sqrtf(t * (1.0f / 128.0f) + 1e-6f);
        const int row = i * 8 + (lane_e >> 3), ch = lane_e & 7;
        #pragma unroll
        for (int hv = 0; hv < DV2; ++hv) { const float* gp = subln + hv * 64 + ch * 8; u32x4 w;
          #pragma unroll
          for (int j = 0; j < 4; ++j) w[j] = cvtpk_s(dd[hv][i][2 * j] * rinv * gp[2 * j], dd[hv][i][2 * j + 1] * rinv * gp[2 * j + 1]);
          *(u32x4*)(Ow + (long)row * OP + hv * 64 + ch * 8) = w; } }
    } else {
    #pragma unroll
    for (int hv = 0; hv < DV2; ++hv) {
    #pragma unroll
    for (int r = 0; r < 16; ++r) { const int orow = crow(r, hie);
      #pragma unroll
      for (int d0 = 0; d0 < 2; ++d0) stg[orow * 64 + d0 * 32 + r32e] = __float2bfloat16(o[2 * hv + d0][r] * rli[r]); }
    asm volatile("s_waitcnt lgkmcnt(0)" ::: "memory");
    #pragma unroll
    for (int i = 0; i < 4; ++i) { const int row = i * 8 + (lane_e >> 3), ch = lane_e & 7; const u32x4 v = *(const u32x4*)(stg + row * 64 + ch * 8); *(u32x4*)(Ow + (long)row * OP + hv * 64 + ch * 8) = v; }
    asm volatile("s_waitcnt lgkmcnt(0)" ::: "memory"); } } }
  asm volatile("s_waitcnt lgkmcnt(0)\n\ts_barrier" ::: "memory");
  #undef DMA_K
  #undef DMA_V
  #undef START
  #undef RESC
  #undef ROT
}
#undef SBAR
#undef WAIT_BAR
}

#define LDS_WAIT() asm volatile("s_waitcnt lgkmcnt(0)" ::: "memory")
__device__ __forceinline__ unsigned f2bf(float f) { unsigned u = __builtin_bit_cast(unsigned, f); return (u + 0x7fffu + ((u >> 16) & 1u)) >> 16; }
__device__ __forceinline__ unsigned pk2(float lo, float hi) { return f2bf(lo) | (f2bf(hi) << 16); }
__device__ __forceinline__ f32x4 cvh4(unsigned a, unsigned b) { return (f32x4){(float)__builtin_bit_cast(_Float16, (unsigned short)(a & 0xffffu)), (float)__builtin_bit_cast(_Float16, (unsigned short)(a >> 16)), (float)__builtin_bit_cast(_Float16, (unsigned short)(b & 0xffffu)), (float)__builtin_bit_cast(_Float16, (unsigned short)(b >> 16))}; }
__device__ __forceinline__ f32x4 ldh4(const bf16_t* p) { const u32x2 w = *(const u32x2*)p; return (f32x4){(float)__builtin_bit_cast(_Float16, (unsigned short)(w.x & 0xffffu)), (float)__builtin_bit_cast(_Float16, (unsigned short)(w.x >> 16)), (float)__builtin_bit_cast(_Float16, (unsigned short)(w.y & 0xffffu)), (float)__builtin_bit_cast(_Float16, (unsigned short)(w.y >> 16))}; }
__device__ __forceinline__ float bf2f(unsigned short b) { return __builtin_bit_cast(float, (unsigned)b << 16); }
__device__ __forceinline__ float wave_sum(float v, int lane) {
#pragma unroll
    for (int o = 1; o < 64; o <<= 1) v += shx(v, lane, o);
    return v;
}
__device__ __forceinline__ int wpos(int mode, int L) {
    if (mode == 1) { const int d = L & 63, fq = 2 * (d >> 5) + ((d >> 3) & 1); return (L & ~255) + ((d >> 4) & 1) * 128 + ((L >> 6) & 3) * 32 + 8 * fq + (d & 7); }
    if (mode == 2) { const int bj = L >= DFF ? 1 : 0, rem = L - bj * DFF; return (rem >> 7) * 256 + bj * 128 + (rem & 127); }
    return L;
}
__device__ __forceinline__ void transpose_item(const float* W, int K, int N, bf16_t* WT, int mode, LAS float* scr, int item, int lane) {
    const int nblk = N / 32, kb = item / nblk, nb = item % nblk, k0 = 64 * kb, n0 = 32 * nb;
    {
        const int rr = lane >> 3, c4 = (lane & 7) * 4;
        f32x4 v[8];
#pragma unroll
        for (int i = 0; i < 8; ++i) v[i] = *(const f32x4*)(W + (size_t)(k0 + 8 * i + rr) * N + n0 + c4);
#pragma unroll
        for (int i = 0; i < 8; ++i) { LAS float* d = scr + (8 * i + rr) * 33 + c4; d[0] = v[i].x; d[1] = v[i].y; d[2] = v[i].z; d[3] = v[i].w; }
    }
    LDS_WAIT(); asm volatile("" ::: "memory");
    const int c = lane & 7;
#pragma unroll
    for (int j = 0; j < 4; ++j) { const int n = (lane >> 3) + 8 * j; const LAS float* s = scr + (8 * c) * 33 + n;
        u32x4 o; o.x = pk2(s[0 * 33], s[1 * 33]); o.y = pk2(s[2 * 33], s[3 * 33]); o.z = pk2(s[4 * 33], s[5 * 33]); o.w = pk2(s[6 * 33], s[7 * 33]);
        *(u32x4*)(WT + (size_t)wpos(mode, n0 + n) * K + k0 + 8 * c) = o; }
    LDS_WAIT(); asm volatile("" ::: "memory");
}


#define XB_TMO      128
#define XB_XCNT(j)  (256  + 64 * (j))
#define XB_XSUB(j)  (1280 + 64 * (j))
#define XB_XGEN(j)  (2304 + 64 * (j))
#define XB_TOP      3328
#define XB_TOPGEN   3392
#define XCD_BAR_WORDS 3456
#define XB_SPIN_CAP (1u << 22)
__device__ __forceinline__ unsigned xb_ld(unsigned* p)              { return __hip_atomic_load(p, __ATOMIC_RELAXED, __HIP_MEMORY_SCOPE_AGENT); }
__device__ __forceinline__ unsigned xb_add(unsigned* p, unsigned v) { return __hip_atomic_fetch_add(p, v, __ATOMIC_RELAXED, __HIP_MEMORY_SCOPE_AGENT); }
__device__ __forceinline__ unsigned xb_xcc_id() { return (unsigned)__builtin_amdgcn_s_getreg((3 << 11) | 20) & 0xFu; }
#define XB_SPIN(cond, bar) do { unsigned _sp = 0; while (cond) { __builtin_amdgcn_s_sleep(1); \
    if ((++_sp & 255u) == 0u) { if (xb_ld(&(bar)[XB_TMO])) break; if (_sp > XB_SPIN_CAP) { atomicAdd(&(bar)[XB_TMO], 1u); break; } } } } while (0)
struct XcdBarrier { unsigned* bar; unsigned x; volatile LAS unsigned* st; };
__device__ __forceinline__ void xcd_barrier_complete(unsigned* bar, unsigned x, unsigned& nloc, unsigned& nx) {
    const unsigned G = gridDim.x * gridDim.y * gridDim.z;
    unsigned sum, cnt, mine, sp = 0u;
    for (;;) {
        sum = 0u; cnt = 0u; mine = 0u;
#pragma unroll
        for (unsigned j = 0; j < 16; ++j) { const unsigned c = xb_ld(&bar[XB_XCNT(j)]); sum += c; cnt += (c > 0u) ? 1u : 0u; mine = (j == x) ? c : mine; }
        if (sum == G) break;
        __builtin_amdgcn_s_sleep(1);
        if ((++sp & 255u) == 0u) { if (xb_ld(&bar[XB_TMO])) break; if (sp > XB_SPIN_CAP) { atomicAdd(&bar[XB_TMO], 1u); break; } }
    }
    nloc = mine > 0u ? mine : 1u; nx = cnt > 0u ? cnt : 1u;
}
__device__ __forceinline__ void xcd_barrier(const XcdBarrier& b) {
    asm volatile("s_waitcnt vmcnt(0)" ::: "memory");
    __syncthreads();
    if (threadIdx.x == 0) {
        unsigned* bar = b.bar;
        __builtin_amdgcn_s_waitcnt(0);
        unsigned nloc = b.st[0], nx = b.st[1];
        if (nloc == 0u) { xcd_barrier_complete(bar, b.x, nloc, nx); b.st[0] = nloc; b.st[1] = nx; }
        const unsigned old = xb_add(&bar[XB_XSUB(b.x)], 1u);
        const unsigned gen = old / nloc;
        if (old + 1u == (gen + 1u) * nloc) {
            __builtin_amdgcn_fence(__ATOMIC_RELEASE, "agent");
            asm volatile("s_waitcnt vmcnt(0)" ::: "memory");
            const unsigned og = xb_add(&bar[XB_TOP], 1u);
            const unsigned tg = og / nx;
            if (og + 1u == (tg + 1u) * nx) xb_add(&bar[XB_TOPGEN], 1u);
            else XB_SPIN(xb_ld(&bar[XB_TOPGEN]) == tg, bar);
            __builtin_amdgcn_fence(__ATOMIC_ACQUIRE, "agent");
            xb_add(&bar[XB_XGEN(b.x)], 1u);
            asm volatile("s_waitcnt vmcnt(0)" ::: "memory");
        } else {
            XB_SPIN(xb_ld(&bar[XB_XGEN(b.x)]) == gen, bar);
            __builtin_amdgcn_fence(__ATOMIC_ACQUIRE, "agent");
            asm volatile("s_waitcnt vmcnt(0)" ::: "memory");
        }
    }
    __syncthreads();
}

struct Args { const float* in[50]; float* out; unsigned char* ws; };

__global__ void __launch_bounds__(512, 2) mk_fwd(Args a) {
    extern __shared__ __attribute__((aligned(16))) unsigned char lds[];
    cg::grid_group grid = cg::this_grid();
    LAS unsigned char* ldsl = (LAS unsigned char*)lds;
    const int G = gridDim.x, bid = blockIdx.x;
    const int wave0 = __builtin_amdgcn_readfirstlane((int)threadIdx.x >> 6);
    if (bid == 0) { for (int i = threadIdx.x; i < XCD_BAR_WORDS; i += 512) __hip_atomic_store((unsigned*)a.ws + i, 0u, __ATOMIC_RELAXED, __HIP_MEMORY_SCOPE_AGENT); }
    for (int i = bid * 512 + threadIdx.x; i < 8 * 128 * 64; i += G * 512) __hip_atomic_store((unsigned*)a.ws + 16384 + i, 0u, __ATOMIC_RELAXED, __HIP_MEMORY_SCOPE_AGENT);
    if (threadIdx.x < 64) ((volatile LAS unsigned*)(ldsl + 131072 + 512))[threadIdx.x] = 0u;
    __syncthreads();
    const int vcu = (G % 8 == 0) ? (bid % 8) * (G / 8) + bid / 8 : bid;
    const int NGW = G * 8;
#define PHASE_VARS int lane; asm volatile("v_mbcnt_lo_u32_b32 %0, -1, 0\n\tv_mbcnt_hi_u32_b32 %0, -1, %0" : "=v"(lane)); const int wave = wave0, tid = wave0 * 64 + lane, gw = vcu * 8 + wave; unsigned char* ws = a.ws; asm volatile("" : "+s"(ws)); (void)lane; (void)gw;
    { PHASE_VARS
    bf16_t* XB = (bf16_t*)(ws + WS_XB);
    float* axc = (float*)(ws + WS_AXC); float* axs = (float*)(ws + WS_AXS); float* rcT = (float*)(ws + WS_RC); float* rsT = (float*)(ws + WS_RS);

    {
        LAS float* scr = (LAS float*)(ldsl + wave * 16384);
        constexpr int I_UP = (DM / 64) * (NUP / 32), I_DN = (DFF / 64) * (DM / 32), I_Q0 = (DM / 64) * (1536 / 32), I_SQ = (DM / 64) * (DM / 32), I_Q2 = (DM / 64) * (3072 / 32);
        constexpr int NITEMS = 4 * I_UP + 4 * I_DN + 2 * I_Q0 + 4 * I_SQ + I_Q2;
#define TR(SRC, KK, NN, DSTOFF, MODE, NI) { if (r < (NI)) { transpose_item(a.in[SRC], KK, NN, (bf16_t*)(ws + (DSTOFF)), MODE, scr, r, lane); continue; } r -= (NI); }
        for (int it = gw; it < NITEMS; it += NGW) {
            int r = it;
            TR(7, DM, NUP, WS_WUP, 2, I_UP) TR(17, DM, NUP, WS_WUP + 11 * MiB, 2, I_UP) TR(32, DM, NUP, WS_WUP + 22 * MiB, 2, I_UP) TR(44, DM, NUP, WS_WUP + 33 * MiB, 2, I_UP)
            TR(10, DFF, DM, WS_WDN, 0, I_DN) TR(20, DFF, DM, WS_WDN + 5767168, 0, I_DN) TR(35, DFF, DM, WS_WDN + 2 * 5767168, 0, I_DN) TR(47, DFF, DM, WS_WDN + 3 * 5767168, 0, I_DN)
            TR(1, DM, 1536, WS_QKV0, 1, I_Q0) TR(38, DM, 1536, WS_QKV3, 1, I_Q0)
            TR(4, DM, DM, WS_WO0, 0, I_SQ) TR(13, DM, DM, WS_FWO, 0, I_SQ) TR(29, DM, DM, WS_WO2, 0, I_SQ) TR(41, DM, DM, WS_WO3, 0, I_SQ)
            TR(23, DM, 3072, WS_QKV2, 0, I_Q2)
        }
#undef TR
        for (int m = gw; m < MROWS; m += NGW) {
            const f32x4* xr = (const f32x4*)(a.in[0] + (size_t)m * DM) + lane; unsigned long long* o8 = (unsigned long long*)(XB + (size_t)m * DM) + lane; unsigned long long* h8 = (unsigned long long*)((bf16_t*)a.out + (size_t)MROWS * DM + (size_t)m * DM) + lane;
#pragma unroll
            for (int j = 0; j < 4; ++j) { const f32x4 v = xr[64 * j]; o8[64 * j] = (unsigned long long)pk2(v.x, v.y) | ((unsigned long long)pk2(v.z, v.w) << 32);
                (void)h8; }
        }
        const int gt = vcu * 512 + tid, GT = G * 512;
        for (int i = gt; i < 512 * 256; i += GT) { const int n = i >> 8, c = i & 255, part = n >> 8, m = n & 255; const float ph = (float)((m * c) & 255) * (1.0f / 256.0f);
            const float v = part ? -__builtin_amdgcn_sinf(ph) : __builtin_amdgcn_cosf(ph); ((bf16_t*)(ws + WS_TT))[i] = (bf16_t)f2bf(v); }
        { bf16_t* A2 = (bf16_t*)(ws + WS_A2);
          for (int i = gt; i < 2048 * 4096 / 2; i += GT) { const int e = i * 2, k = e >> 12, c = e & 4095, part = c >> 11, s = c & 2047;
              const float p0 = (float)((k * s) & 4095) * (1.0f / 4096.0f), p1 = (float)((k * (s + 1)) & 4095) * (1.0f / 4096.0f);
              const float v0 = part ? __builtin_amdgcn_sinf(p0) : __builtin_amdgcn_cosf(p0), v1 = part ? __builtin_amdgcn_sinf(p1) : __builtin_amdgcn_cosf(p1);
              ((unsigned*)A2)[i] = pk2(v0, v1); } }
        for (int i = gt; i < 64 * 16; i += GT) { const int t = i >> 4, f = i & 15; const float inv = powf(10000.0f, -(float)(2 * f) / 32.0f); const float ang = (float)t * inv; axc[i] = cosf(ang); axs[i] = sinf(ang); }
        for (int i = gt; i < 4096 * 8; i += GT) { const int t = i >> 3, f = i & 7; const float inv = powf(500000.0f, -(float)(2 * f) / 16.0f); const float ang = (float)t * inv; rcT[i] = cosf(ang); rsT[i] = sinf(ang); }
    }
    }
    grid.sync();
    XcdBarrier xbar; xbar.bar = (unsigned*)a.ws; xbar.x = xb_xcc_id(); xbar.st = (volatile LAS unsigned*)(ldsl + 131072 + 512);
    if (threadIdx.x == 0) (void)xb_add(&xbar.bar[XB_XCNT(xbar.x)], 1u);
#define GSYNC() xcd_barrier(xbar)
    float* OUT = a.out;

    for (int l = 0; l < 4; ++l) {
        const int kind = (l == 3) ? 0 : l;
        for (int h = 0; h < 2; ++h) {
            const char* rA; size_t rBoff; int rK; const float* rbias = nullptr; const float* lng; const float* lnb;
            if (h == 0) {
                if (kind == 0) {
                    { PHASE_VARS
                      pg8::StaticOrder S; S.init(MROWS / 256, 1536 / 256, G, bid);
                      pg8::MapStd MP{(const char*)(ws + WS_XB), (const char*)(ws + (l == 0 ? WS_QKV0 : WS_QKV3)), (size_t)DM * 2, (size_t)DM * 2};
                      pg8::EpiQkvGqa E{(GAS bf16_t*)(ws + WS_QKV), (const GAS float*)(l == 0 ? a.in[2] : a.in[39]), (const GAS float*)(l == 0 ? a.in[3] : a.in[40]), (const GAS float*)(ws + WS_AXC), (const GAS float*)(ws + WS_AXS)};
                      pg8::gemm_phase<pg8::EpiQkvGqa, pg8::MapStd, true>(tid, ldsl, DM, DM, DM, MP, S, E); }
                    GSYNC();
                    { PHASE_VARS
                      const attn_body::bf16* QKV = (const attn_body::bf16*)(ws + WS_QKV); attn_body::bf16* O = (attn_body::bf16*)(ws + WS_O_GQA);
                      float gq = fabsf((l == 0 ? a.in[2] : a.in[39])[lane]), gk = fabsf((l == 0 ? a.in[3] : a.in[40])[lane]);
#pragma unroll
                      for (int o = 1; o < 64; o <<= 1) { gq = fmaxf(gq, shx(gq, lane, o)); gk = fmaxf(gk, shx(gk, lane, o)); }
                      const bool bounded = __builtin_amdgcn_readfirstlane((int)(11.8f * gq * gk < 90.0f)) != 0;
                      if (bounded) {
                        for (int U = vcu; U < 2048; U += G) {
                          const int grp = U >> 6, rest = U & 63, g = rest >> 4, qb = rest & 15, b = grp >> 2, kvh = grp & 3, hq = kvh * 4 + g;
                          const attn_body::bf16* base = QKV + (size_t)b * SEQ * 1536;
                          attn_body::attn_unit<8, 1536, 1, true>(qb * 256, base + hq * 64, base + 1024 + kvh * 64, base + 1280 + kvh * 64, O + (size_t)b * SEQ * DM + hq * 64, (char*)lds, tid);
                        }
                      } else {
                        for (int U = vcu; U < 2048; U += G) {
                          const int grp = U >> 6, rest = U & 63, g = rest >> 4, qb = rest & 15, b = grp >> 2, kvh = grp & 3, hq = kvh * 4 + g;
                          const attn_body::bf16* base = QKV + (size_t)b * SEQ * 1536;
                          attn_body::attn_unit<8, 1536, 1, false>(qb * 256, base + hq * 64, base + 1024 + kvh * 64, base + 1280 + kvh * 64, O + (size_t)b * SEQ * DM + hq * 64, (char*)lds, tid);
                        }
                      } }
                    GSYNC();
                    rA = (const char*)(a.ws + WS_O_GQA); rBoff = (l == 0 ? WS_WO0 : WS_WO3); rK = DM;
                } else if (kind == 1) {
                    { PHASE_VARS
                      const bf16_t* XB = (const bf16_t*)(ws + WS_XB); bf16_t* XE = (bf16_t*)(ws + WS_XE); bf16_t* XO = XE + (size_t)NB * 2048 * DM;
                      for (int r = gw; r < NB * 2048; r += NGW) {
                          const int b = r >> 11, sidx = r & 2047;
                          const u32x4* p = (const u32x4*)(XB + ((size_t)b * SEQ + sidx) * DM) + lane; const u32x4* q = (const u32x4*)(XB + ((size_t)b * SEQ + ((SEQ - sidx) & (SEQ - 1))) * DM) + lane;
                          u32x4* pe = (u32x4*)(XE + (size_t)r * DM) + lane; u32x4* po = (u32x4*)(XO + (size_t)r * DM) + lane;
#pragma unroll
                          for (int j = 0; j < 2; ++j) { const u32x4 x1 = p[64 * j], x2 = q[64 * j]; u32x4 e, o;
#pragma unroll
                              for (int t = 0; t < 4; ++t) { const float a0 = bf2f(x1[t] & 0xffff), a1 = bf2f(x1[t] >> 16), b0 = bf2f(x2[t] & 0xffff), b1 = bf2f(x2[t] >> 16);
                                  e[t] = pk2(a0 + b0, a1 + b1); o[t] = pk2(a0 - b0, a1 - b1); }
                              if (sidx == 0) { e = x1; o = (u32x4){0u, 0u, 0u, 0u}; }
                              pe[64 * j] = e; po[64 * j] = o; }
                      }
                      const int gt = vcu * 512 + tid;
                      if (gt < NB * DM) { const int b = gt >> 10, ch = gt & 1023, g = ch >> 8, m = ch & 255; const bf16_t* xr = XB + ((size_t)b * SEQ + 2048) * DM + g * 256; float acc_ = 0.f;
                          for (int c = 0; c < 256; ++c) acc_ += bf2f(xr[c]) * __builtin_amdgcn_cosf((float)((m * c) & 255) * (1.0f / 256.0f));
                          ((float*)(ws + WS_YCH))[gt] = acc_; }
                    }
                    GSYNC();
                    { PHASE_VARS
                      pg8::StaticOrder S; S.init(8, 64, G, bid);
                      pg8::MapF1 MP{(const char*)(ws + WS_TT), (const char*)(ws + WS_XE)};
                      pg8::EpiBf16<1> E{(GAS bf16_t*)(ws + WS_YT), 1.0f, (const GAS float*)nullptr};
                      pg8::gemm_phase<pg8::EpiBf16<1>, pg8::MapF1, true>(tid, ldsl, 256, DM, 256, MP, S, E); }
                    GSYNC();
                    { PHASE_VARS
                      { const bf16_t* YT = (const bf16_t*)(ws + WS_YT); const float* ych = (const float*)(ws + WS_YCH); bf16_t* Zb = (bf16_t*)OUT;
                        for (int r = gw; r < NB * DM; r += NGW) { const u32x4* p = (const u32x4*)(YT + (size_t)r * 4096) + lane; float sacc = 0.f;
#pragma unroll
                            for (int j = 0; j < 4; ++j) { const u32x4 w = p[64 * j];
#pragma unroll
                                for (int t = 0; t < 4; ++t) sacc += bf2f((unsigned short)(w[t] & 0xffffu)) - bf2f((unsigned short)(w[t] >> 16)); }
                            sacc = wave_sum(sacc, lane);
                            if (lane == 0) Zb[((size_t)(r >> 10) * SEQ + 2048) * DM + (r & 1023)] = (bf16_t)f2bf((sacc + ych[r]) * (1.0f / 1024.0f)); } }
                      pg8::StaticOrder S; S.init(128, 4, G, bid);
                      pg8::MapF2 MP{(const char*)(ws + WS_A2), (const char*)(ws + WS_YT)};
                      pg8::EpiF2s E{(GAS bf16_t*)OUT, 1.0f / 1024.0f, (const GAS float*)(ws + WS_YCH), (GAS float*)(ws + WS_R + 128 * MiB)};
                      pg8::gemm_phase<pg8::EpiF2s, pg8::MapF2, true>(tid, ldsl, 4096, 4096, 2048, MP, S, E); }
                    GSYNC();
                    rA = (const char*)OUT; rBoff = WS_FWO; rK = DM; rbias = a.in[14];
                } else {
                    { PHASE_VARS
                      pg8::StaticOrder S; S.init(MROWS / 256, 3072 / 256, G, bid);
                      pg8::MapStd MP{(const char*)(ws + WS_XB), (const char*)(ws + WS_QKV2), (size_t)DM * 2, (size_t)DM * 2};
                      pg8::EpiQkvDiff E{(GAS bf16_t*)(ws + WS_QKV), (const GAS float*)(ws + WS_RC), (const GAS float*)(ws + WS_RS)};
                      pg8::gemm_phase<pg8::EpiQkvDiff, pg8::MapStd, true>(tid, ldsl, DM, DM, DM, MP, S, E); }
                    GSYNC();
                    { PHASE_VARS
                      const attn_body::bf16* QKV = (const attn_body::bf16*)(ws + WS_QKV); attn_body::bf16* O1 = (attn_body::bf16*)(ws + WS_O12);
                      float d1 = a.in[24][lane] * a.in[25][lane], d2 = a.in[26][lane] * a.in[27][lane];
                      d1 = wave_sum(d1, lane); d2 = wave_sum(d2, lane);
                      const float lam = expf(d1) - expf(d2) + LAMBDA_INIT2;
                      for (int i = 0; i < 8; ++i) {
                          const int V = (i >> 1) * G + vcu; if (V >= 1024) break;
                          const int c = i & 1, grp = V >> 4, qb = V & 15, b = grp >> 3, hh = grp & 7;
                          const attn_body::bf16* base = QKV + (size_t)b * SEQ * 3072;
                          attn_body::attn_unit<8, 3072, 2>(qb * 256, base + (2 * hh + c) * 64, base + 1024 + (2 * hh + c) * 64, base + 2048 + hh * 128,
                                                  O1 + (size_t)b * SEQ * DM + hh * 128, (char*)lds, tid, c == 1, lam, a.in[28]);
                      } }
                    GSYNC();
                    rA = (const char*)(a.ws + WS_O12); rBoff = WS_WO2; rK = DM;
                }
                lng = a.in[l == 0 ? 5 : l == 1 ? 15 : l == 2 ? 30 : 42]; lnb = a.in[l == 0 ? 6 : l == 1 ? 16 : l == 2 ? 31 : 43];
            } else {
                const float* cw = a.in[l == 0 ? 8 : l == 1 ? 18 : l == 2 ? 33 : 45]; const float* cb = a.in[l == 0 ? 9 : l == 1 ? 19 : l == 2 ? 34 : 46];
                { PHASE_VARS
                  pg8::StaticOrder S; S.init(MROWS / 256, NUP / 256, G, bid);
                  pg8::MapStd MP{(const char*)(ws + WS_XB), (const char*)(ws + WS_WUP + (size_t)l * 11 * MiB), (size_t)DM * 2, (size_t)DM * 2};
                  pg8::EpiUpConv E{(GAS bf16_t*)(ws + WS_G), (GAS bf16_t*)(ws + WS_E), (const GAS float*)cw, (const GAS float*)cb};
                  pg8::gemm_phase<pg8::EpiUpConv, pg8::MapStd, true>(tid, ldsl, DM, DM, DM, MP, S, E); }
                GSYNC();
                { PHASE_VARS
                  bf16_t* Gb = (bf16_t*)(ws + WS_G); const bf16_t* Eb = (const bf16_t*)(ws + WS_E);
                  for (int it = gw; it < (MROWS / 32) * 6; it += NGW) {
                    const int ri = it / 6, ch = it - ri * 6;
                    const int blk = ri >> 1, side = ri & 1, row = blk * 64 + (side ? 63 : 0), s = row & (SEQ - 1);
                    const bf16_t* eu; const bf16_t* em; const bf16_t* ed; bool hasu = true, hasd = true;
                    if (side == 0) { hasu = (s != 0); eu = Eb + ((size_t)(blk - (hasu ? 1 : 0)) * 4 + 3) * NUP; em = Eb + ((size_t)blk * 4 + 0) * NUP; ed = Eb + ((size_t)blk * 4 + 1) * NUP; }
                    else { hasd = (s != SEQ - 1); eu = Eb + ((size_t)blk * 4 + 2) * NUP; em = Eb + ((size_t)blk * 4 + 3) * NUP; ed = Eb + ((size_t)(blk + (hasd ? 1 : 0)) * 4 + 0) * NUP; }
                    const float fu = hasu ? 1.f : 0.f, fd = hasd ? 1.f : 0.f;
                    const int c = ch * 512 + 8 * lane;
                    if (c < DFF) {
                        f32x4 hgv[2][2];
#pragma unroll
                        for (int p = 0; p < 2; ++p) { const u32x4 wu = *(const u32x4*)(eu + c + p * DFF), wm = *(const u32x4*)(em + c + p * DFF), wd = *(const u32x4*)(ed + c + p * DFF);
#pragma unroll
                            for (int q4 = 0; q4 < 2; ++q4) { const int cc = c + p * DFF + 4 * q4;
                                const f32x4 u4 = cvh4(wu[2 * q4], wu[2 * q4 + 1]) * fu, m4 = cvh4(wm[2 * q4], wm[2 * q4 + 1]), d4 = cvh4(wd[2 * q4], wd[2 * q4 + 1]) * fd;
                                hgv[p][q4] = *(const f32x4*)(cb + cc) + *(const f32x4*)(cw + cc) * u4 + *(const f32x4*)(cw + NUP + cc) * m4 + *(const f32x4*)(cw + 2 * NUP + cc) * d4; } }
                        u32x4 w;
                        w.x = pk2(pg8::silu_mul(hgv[0][0][0], hgv[1][0][0]), pg8::silu_mul(hgv[0][0][1], hgv[1][0][1])); w.y = pk2(pg8::silu_mul(hgv[0][0][2], hgv[1][0][2]), pg8::silu_mul(hgv[0][0][3], hgv[1][0][3]));
                        w.z = pk2(pg8::silu_mul(hgv[0][1][0], hgv[1][1][0]), pg8::silu_mul(hgv[0][1][1], hgv[1][1][1])); w.w = pk2(pg8::silu_mul(hgv[0][1][2], hgv[1][1][2]), pg8::silu_mul(hgv[0][1][3], hgv[1][1][3]));
                        *(u32x4*)(Gb + (size_t)row * DFF + c) = w;
                    }
                  } }
                GSYNC();
                rA = (const char*)(a.ws + WS_G); rBoff = WS_WDN + (size_t)l * 5767168; rK = DFF;
                lng = a.in[l == 0 ? 11 : l == 1 ? 21 : l == 2 ? 36 : 48]; lnb = a.in[l == 0 ? 12 : l == 1 ? 22 : l == 2 ? 37 : 49];
            }
            { PHASE_VARS
              pg8::StaticOrder S; S.init(MROWS / 256, DM / 256, G, bid);
              pg8::MapStd MP{rA, (const char*)(ws + rBoff), (size_t)rK * 2, (size_t)rK * 2};
              pg8::PanelStats st{(unsigned*)(ws + 89 * MiB), (unsigned*)ws + 16384 + (l * 2 + h) * 128 * 64, ldsl + 131072 + 1024};
              const int q = 2 * l + h; bf16_t* XHo = (bf16_t*)OUT + (size_t)MROWS * DM;
              constexpr int QB16 = 3;
              pg8::EpiResidLn E{(GAS float*)(q == 7 ? OUT : nullptr), (GAS bf16_t*)(q == 7 ? nullptr : (bf16_t*)(ws + WS_XB)),
                                 (const GAS bf16_t*)(q <= QB16 ? (bf16_t*)(ws + WS_XB) : q == 7 ? (bf16_t*)(ws + WS_XH7) : XHo), (GAS bf16_t*)((q == 7 || q < QB16) ? nullptr : q == 6 ? (bf16_t*)(ws + WS_XH7) : XHo), (const GAS float*)rbias, (const GAS float*)lng, (const GAS float*)lnb, st, q <= QB16};
              pg8::gemm_phase<pg8::EpiResidLn, pg8::MapStd, true>(tid, ldsl, rK, rK, rK, MP, S, E); }
            GSYNC();
        }
    }
}

extern "C" void kernel_launch(void* const* d_in, const int* in_sizes, int n_in, void* d_out, int out_size, void* d_ws, size_t ws_size, hipStream_t stream) {
    static int grid = 0;
    if (grid == 0) {
        if (n_in != 50 || out_size != MROWS * DM || ws_size < WS_NEED) { fprintf(stderr, "kernel_launch: unexpected shapes n_in %d out %d ws %zu\n", n_in, out_size, ws_size); grid = -1; return; }
        int dev = 0, cus = 0, per_cu = 0;
        (void)hipGetDevice(&dev); (void)hipDeviceGetAttribute(&cus, hipDeviceAttributeMultiprocessorCount, dev);
        (void)hipFuncSetAttribute((const void*)mk_fwd, hipFuncAttributeMaxDynamicSharedMemorySize, LDS_BYTES);
        (void)hipOccupancyMaxActiveBlocksPerMultiprocessor(&per_cu, (const void*)mk_fwd, 512, LDS_BYTES);
        if (per_cu < 1) per_cu = 1;
        grid = cus * per_cu;
        fprintf(stderr, "kernel_launch: grid %d (cus %d x %d)\n", grid, cus, per_cu);
    }
    if (grid < 0) return;
    Args a{};
    for (int i = 0; i < 50; ++i) a.in[i] = (const float*)d_in[i];
    a.out = (float*)d_out; a.ws = (unsigned char*)d_ws;
    void* args[] = {&a};
    hipError_t e = hipLaunchCooperativeKernel((const void*)mk_fwd, dim3(grid), dim3(512), args, LDS_BYTES, stream);
    if (e != hipSuccess) fprintf(stderr, "cooperative launch failed: %s (grid %d)\n", hipGetErrorString(e), grid);
}
```

```cpp
#include <hip/hip_runtime.h>
#include <hip/hip_cooperative_groups.h>
#include <hip/hip_bf16.h>
#include <cstdio>
#include <cstdint>
#include <cmath>
namespace cg = cooperative_groups;

#define LAS __attribute__((address_space(3)))
#define GAS __attribute__((address_space(1)))
typedef unsigned short bf16_t;
typedef short bf16x8 __attribute__((ext_vector_type(8)));
typedef float f32x4 __attribute__((ext_vector_type(4)));
typedef float f32x2 __attribute__((ext_vector_type(2)));
typedef unsigned u32x4 __attribute__((ext_vector_type(4)));
typedef unsigned u32x2 __attribute__((ext_vector_type(2)));

constexpr int DM = 1024, NB = 8, SEQ = 4096, MROWS = NB * SEQ, DFF = 2816, NUP = 2 * DFF;
constexpr float LN_EPS = 1e-5f, RMS_EPS = 1e-6f;
constexpr float ALPHA = 1.681792830507429f;
constexpr float C2 = 0.125f * 1.4426950408889634f;
constexpr float LAMBDA_INIT2 = 0.47071301834358366f;

constexpr size_t MiB = 1u << 20;
constexpr size_t WS_WUP = 1 * MiB;
constexpr size_t WS_WDN = 45 * MiB;
constexpr size_t WS_QKV0 = 67 * MiB, WS_WO0 = 70 * MiB, WS_FWO = 72 * MiB, WS_QKV2 = 74 * MiB, WS_WO2 = 80 * MiB, WS_QKV3 = 82 * MiB, WS_WO3 = 85 * MiB;
constexpr size_t WS_TT = 87 * MiB;
constexpr size_t WS_AXC = 88 * MiB, WS_AXS = WS_AXC + 4096, WS_RC = WS_AXC + 65536, WS_RS = WS_RC + 131072;
constexpr size_t WS_XB = 90 * MiB;
constexpr size_t WS_R = 154 * MiB;
constexpr size_t WS_QKV = WS_R;
constexpr size_t WS_O_GQA = WS_R + 96 * MiB;
constexpr size_t WS_O12 = WS_R + 192 * MiB;
constexpr size_t WS_YT = WS_R + 64 * MiB;
constexpr size_t WS_XE = WS_R;
constexpr size_t WS_YCH = 88 * MiB + 512 * 1024;
constexpr size_t WS_A2 = WS_R + 294 * MiB;
constexpr size_t WS_G = WS_R;
constexpr size_t WS_E = WS_R + 176 * MiB;
constexpr size_t WS_XH7 = WS_R + 230 * MiB;
constexpr size_t WS_NEED = 512 * MiB;

constexpr int LDS_BYTES = 147456;

__device__ __forceinline__ float shx(float v, int lane, int m) { return __builtin_bit_cast(float, __builtin_amdgcn_ds_bpermute((lane ^ m) << 2, __builtin_bit_cast(int, v))); }
__device__ __forceinline__ float xsum16(float v) { auto r = __builtin_amdgcn_permlane16_swap(__float_as_uint(v), __float_as_uint(v), false, false); return __uint_as_float(r[0]) + __uint_as_float(r[1]); }
__device__ __forceinline__ float xsum32(float v) { auto r = __builtin_amdgcn_permlane32_swap(__float_as_uint(v), __float_as_uint(v), false, false); return __uint_as_float(r[0]) + __uint_as_float(r[1]); }
__device__ __forceinline__ float xpart16(float v, bool oddrow) { auto r = __builtin_amdgcn_permlane16_swap(__float_as_uint(v), __float_as_uint(v), false, false); return __uint_as_float(oddrow ? r[0] : r[1]); }
namespace pg8 {
constexpr int BM = 256, BK = 64, HALF = 128, HTB = HALF * BK * 2, NXCD = 8, WGM = 8;
__host__ __device__ __forceinline__ int lds_byte(int r, int c) { const int st = (r >> 4) * 2 + (c >> 5), rr = r & 15, cc = c & 31, ob = rr * 64 + cc * 2; return st * 1024 + (ob ^ (((ob >> 9) & 1) << 5)); }
__host__ __device__ __forceinline__ void stage_rc(int b, int& R, int& C) { const int st = b / 1024, sb = b % 1024, swz = sb ^ (((sb >> 9) & 1) << 5); R = (st >> 1) * 16 + swz / 64; C = (st & 1) * 32 + (swz % 64) / 2; }
__host__ __device__ __forceinline__ int perm32(int rho) { const int n = rho >> 4, i = rho & 15; return 8 * (i >> 2) + 4 * n + (i & 3); }

struct Unit { int pm, pn; };
struct StaticOrder {
    int nM, nN, nwg, G, c;
    __device__ void init(int nM_, int nN_, int G_, int c_) { nM = nM_; nN = nN_; nwg = nM * nN; G = G_; c = c_; }
    __device__ bool next(int i, Unit& u) const {
        const long L = (long)i * G + c; if (L >= nwg) return false;
        int wgid = (int)L; { const int q = nwg / NXCD, r = nwg % NXCD, xcd = wgid % NXCD, off = wgid / NXCD; wgid = (xcd < r ? xcd * (q + 1) : r * (q + 1) + (xcd - r) * q) + off; }
        const int nig = WGM * nN, gid = wgid / nig, fm = gid * WGM, gsz = (nM - fm) < WGM ? (nM - fm) : WGM;
        u.pm = fm + ((wgid % nig) % gsz); u.pn = (wgid % nig) / gsz; return true;
    }
};
__device__ __forceinline__ unsigned cvt_pk_f16(float lo, float hi) { unsigned r; asm volatile("v_cvt_pk_f16_f32 %0, %1, %2" : "=v"(r) : "v"(lo), "v"(hi)); return r; }
__device__ __forceinline__ unsigned cvt_pk_bf16(float lo, float hi) { unsigned r; asm volatile("v_cvt_pk_bf16_f32 %0, %1, %2" : "=v"(r) : "v"(lo), "v"(hi)); return r; }

struct MapStd { const char* A; const char* B; size_t lda2, ldb2;
    __device__ __forceinline__ void ptrs(const Unit& u, const char*& a, const char*& b) const { a = A + (size_t)u.pm * 256 * lda2; b = B + (size_t)u.pn * 256 * ldb2; } };
struct MapF1 { const char* Tt; const char* XE;
    __device__ __forceinline__ void ptrs(const Unit& u, const char*& a, const char*& b) const { a = Tt + (size_t)(u.pm & 1) * 256 * 512; b = XE + (size_t)(u.pm & 1) * (32u << 20) + (size_t)u.pn * 256 * 2048 + (size_t)(u.pm >> 1) * 512; } };
struct MapF2 { const char* A2; const char* YT;
    __device__ __forceinline__ void ptrs(const Unit& u, const char*& a, const char*& b) const { const size_t po = (size_t)((u.pm >> 3) & 1) * 4096;
        a = A2 + (size_t)(u.pm & 7) * 256 * 8192 + po; b = YT + (size_t)(u.pm >> 4) * (1024u * 8192u) + (size_t)u.pn * 256 * 8192 + po; } };

template <class T> __device__ __forceinline__ T gld(const GAS void* ub, unsigned boff) { return *(const GAS T*)((const GAS char*)ub + boff); }
template <class T> __device__ __forceinline__ void gst(GAS void* ub, unsigned boff, const T& v) { *(GAS T*)((GAS char*)ub + boff) = v; }
struct EpiResid { static constexpr bool PERM = false, APERM = false;
    const GAS float* X; GAS float* Y; const GAS float* bias;
    __device__ __forceinline__ void operator()(f32x4 (&acc)[2][2][4][2], const Unit& u, int wr, int wc, int lane) const {
        const int fr = lane & 15, fq = lane >> 4;
        const int colu = u.pn * BM + wc * 32;
        f32x4 bv[2][2];
#pragma unroll
        for (int bj = 0; bj < 2; ++bj)
#pragma unroll
            for (int n = 0; n < 2; ++n) bv[bj][n] = bias ? gld<f32x4>(bias + colu + bj * HALF + n * 16, 16u * fq) : (f32x4){0.f, 0.f, 0.f, 0.f};
#pragma unroll
        for (int ai = 0; ai < 2; ++ai) {
            const size_t uoff = (size_t)(u.pm * BM + ai * HALF + wr * 64) * DM + colu;
            const GAS float* xu = X + uoff; GAS float* yu = Y + uoff;
#pragma unroll
            for (int m = 0; m < 4; ++m) { const unsigned lo = (unsigned)((m * 16 + fr) * DM + 4 * fq) * 4u;
                f32x4 xv[2][2];
#pragma unroll
                for (int bj = 0; bj < 2; ++bj)
#pragma unroll
                    for (int n = 0; n < 2; ++n) xv[bj][n] = gld<f32x4>(xu + bj * HALF + n * 16, lo);
#pragma unroll
                for (int bj = 0; bj < 2; ++bj)
#pragma unroll
                    for (int n = 0; n < 2; ++n) gst<f32x4>(yu + bj * HALF + n * 16, lo, xv[bj][n] * ALPHA + acc[ai][bj][m][n] + bv[bj][n]);
                asm volatile("" ::: "memory"); }
        }
    }
};
struct PanelStats {
    unsigned* xbuf;
    unsigned* cnt;
    LAS unsigned char* tl;
    __device__ __forceinline__ void run(const f32x4 (&v)[2][2][4][2], const Unit& u, int wr, int wc, int lane) const {
        const int fr = lane & 15, fq = lane >> 4, wid = wr * 4 + wc;
        LAS f32x2* P = (LAS f32x2*)tl; LAS f32x2* S = (LAS f32x2*)(tl + 8192);
#pragma unroll
        for (int ai = 0; ai < 2; ++ai)
#pragma unroll
            for (int m = 0; m < 4; ++m) {
                float s = 0.f;
#pragma unroll
                for (int bj = 0; bj < 2; ++bj)
#pragma unroll
                    for (int n = 0; n < 2; ++n) { const f32x4 x = v[ai][bj][m][n]; s += (x[0] + x[1]) + (x[2] + x[3]); }
                s = xsum32(xsum16(s));
                const float mw = s * (1.0f / 64.0f); float q = 0.f;
#pragma unroll
                for (int bj = 0; bj < 2; ++bj)
#pragma unroll
                    for (int n = 0; n < 2; ++n) { const f32x4 d = v[ai][bj][m][n] - mw; q += (d[0] * d[0] + d[1] * d[1]) + (d[2] * d[2] + d[3] * d[3]); }
                q = xsum32(xsum16(q));
                if (fq == 0) P[(ai * HALF + wr * 64 + m * 16 + fr) * 4 + wc] = (f32x2){mw, q};
            }
        asm volatile("s_waitcnt lgkmcnt(0)" ::: "memory"); __builtin_amdgcn_s_barrier(); asm volatile("" ::: "memory");
        const int row = wid * 32 + (lane & 31);
        if (lane < 32) {
            const f32x2 a = P[row * 4 + 0], b = P[row * 4 + 1], c = P[row * 4 + 2], d = P[row * 4 + 3];
            const float mt = (a.x + b.x + c.x + d.x) * 0.25f;
            const float da = a.x - mt, db = b.x - mt, dc = c.x - mt, dd = d.x - mt;
            const float m2 = (a.y + b.y) + (c.y + d.y) + 64.0f * ((da * da + db * db) + (dc * dc + dd * dd));
            unsigned long long* slot = (unsigned long long*)xbuf + ((size_t)(u.pm * BM + row) * 4 + u.pn);
            __hip_atomic_store(slot, ((unsigned long long)__float_as_uint(m2) << 32) | __float_as_uint(mt), __ATOMIC_RELAXED, __HIP_MEMORY_SCOPE_AGENT);
        }
        asm volatile("s_waitcnt vmcnt(0)" ::: "memory");
        if (lane == 0) __hip_atomic_fetch_add(cnt + 64 * u.pm, 1u, __ATOMIC_RELAXED, __HIP_MEMORY_SCOPE_AGENT);
        if (wid == 0) {
            unsigned sp = 0;
            for (;;) {
                if ((unsigned)__builtin_amdgcn_readfirstlane(__hip_atomic_load(cnt + 64 * u.pm, __ATOMIC_RELAXED, __HIP_MEMORY_SCOPE_AGENT)) >= 32u) break;
                if (++sp > (1u << 24)) break;
                __builtin_amdgcn_s_sleep(2);
            }
            __builtin_amdgcn_fence(__ATOMIC_ACQUIRE, "agent");
        }
        asm volatile("s_waitcnt vmcnt(0) lgkmcnt(0)" ::: "memory"); __builtin_amdgcn_s_barrier(); asm volatile("" ::: "memory");
        if (lane < 32) {
            const unsigned long long* slot = (const unsigned long long*)xbuf + (size_t)(u.pm * BM + row) * 4; float mt[4], m2[4]; float ms = 0.f;
#pragma unroll
            for (int t = 0; t < 4; ++t) { const unsigned long long w = __hip_atomic_load(slot + t, __ATOMIC_RELAXED, __HIP_MEMORY_SCOPE_AGENT); mt[t] = __uint_as_float((unsigned)w); m2[t] = __uint_as_float((unsigned)(w >> 32)); ms += mt[t]; }
            const float mean = ms * 0.25f; float q = 0.f;
#pragma unroll
            for (int t = 0; t < 4; ++t) { const float dm = mt[t] - mean; q += m2[t] + 256.0f * dm * dm; }
            S[row] = (f32x2){mean, 1.0f / sqrtf(q * (1.0f / 1024.0f) + LN_EPS)};
        }
        asm volatile("s_waitcnt lgkmcnt(0)" ::: "memory"); __builtin_amdgcn_s_barrier(); asm volatile("" ::: "memory");
    }
};
struct EpiResidLn { static constexpr bool PERM = true, APERM = false;
    GAS float* Y; GAS bf16_t* XBo; const GAS bf16_t* XHr; GAS bf16_t* XHw; const GAS float* bias; const GAS float* g; const GAS float* b; PanelStats st; bool xbf;
    static __device__ __forceinline__ float h2f(unsigned short hbits) { return (float)__builtin_bit_cast(_Float16, hbits); }
    __device__ __forceinline__ void operator()(f32x4 (&acc)[2][2][4][2], const Unit& u, int wr, int wc, int lane) const {
        const int fr = lane & 15, fq = lane >> 4;
        const int colu = u.pn * BM + wc * 32;
        {
            f32x4 bv[2][2];
#pragma unroll
            for (int bj = 0; bj < 2; ++bj)
#pragma unroll
                for (int n = 0; n < 2; ++n) bv[bj][n] = bias ? gld<f32x4>(bias + colu + bj * HALF + n * 4, 32u * fq) : (f32x4){0.f, 0.f, 0.f, 0.f};
#pragma unroll
            for (int ai = 0; ai < 2; ++ai) {
                const GAS bf16_t* xu = XHr + (size_t)(u.pm * BM + ai * HALF + wr * 64) * DM + colu;
#pragma unroll
                for (int m = 0; m < 4; ++m) { const unsigned lo = (unsigned)((m * 16 + fr) * DM + 8 * fq) * 2u;
                    u32x4 xw[2];
#pragma unroll
                    for (int bj = 0; bj < 2; ++bj) xw[bj] = gld<u32x4>(xu + bj * HALF, lo);
#pragma unroll
                    for (int bj = 0; bj < 2; ++bj)
#pragma unroll
                        for (int n = 0; n < 2; ++n) { const unsigned w0 = xw[bj][2 * n], w1 = xw[bj][2 * n + 1];
                            const f32x4 xv = xbf ? (f32x4){__uint_as_float(w0 << 16), __uint_as_float(w0 & 0xffff0000u), __uint_as_float(w1 << 16), __uint_as_float(w1 & 0xffff0000u)}
                                                 : (f32x4){h2f((unsigned short)(w0 & 0xffffu)), h2f((unsigned short)(w0 >> 16)), h2f((unsigned short)(w1 & 0xffffu)), h2f((unsigned short)(w1 >> 16))};
                            acc[ai][bj][m][n] = xv * ALPHA + acc[ai][bj][m][n] + bv[bj][n]; }
                    asm volatile("" : "+v"(acc[ai][0][m][0]), "+v"(acc[ai][0][m][1]), "+v"(acc[ai][1][m][0]), "+v"(acc[ai][1][m][1]));
                    if (m & 1) asm volatile("" ::: "memory"); }
            }
        }
        st.run(acc, u, wr, wc, lane);
        const LAS f32x2* S = (const LAS f32x2*)(st.tl + 8192);
        f32x4 gv[2][2], bb[2][2];
#pragma unroll
        for (int bj = 0; bj < 2; ++bj)
#pragma unroll
            for (int n = 0; n < 2; ++n) { gv[bj][n] = gld<f32x4>(g + colu + bj * HALF + n * 4, 32u * fq); bb[bj][n] = gld<f32x4>(b + colu + bj * HALF + n * 4, 32u * fq); }
#pragma unroll
        for (int ai = 0; ai < 2; ++ai) {
            const size_t uoff = (size_t)(u.pm * BM + ai * HALF + wr * 64) * DM + colu;
            GAS float* yu = Y + uoff; GAS bf16_t* bu = XBo + uoff; GAS bf16_t* hu = XHw + uoff;
#pragma unroll
            for (int m = 0; m < 4; ++m) { const int r = ai * HALF + wr * 64 + m * 16 + fr; const f32x2 sr = S[r];
                const unsigned lo = (unsigned)((m * 16 + fr) * DM + 8 * fq);
#pragma unroll
                for (int bj = 0; bj < 2; ++bj) {
                    const f32x4 o0 = (acc[ai][bj][m][0] - sr.x) * sr.y * gv[bj][0] + bb[bj][0], o1 = (acc[ai][bj][m][1] - sr.x) * sr.y * gv[bj][1] + bb[bj][1];
                    if (Y) { gst<f32x4>(yu + bj * HALF, lo * 4u, o0); gst<f32x4>(yu + bj * HALF + 4, lo * 4u, o1); }
                    if (XHw) { u32x4 wh; wh.x = cvt_pk_f16(o0[0], o0[1]); wh.y = cvt_pk_f16(o0[2], o0[3]); wh.z = cvt_pk_f16(o1[0], o1[1]); wh.w = cvt_pk_f16(o1[2], o1[3]); gst<u32x4>(hu + bj * HALF, lo * 2u, wh); }
                    if (XBo) { u32x4 w; w.x = cvt_pk_bf16(o0[0], o0[1]); w.y = cvt_pk_bf16(o0[2], o0[3]); w.z = cvt_pk_bf16(o1[0], o1[1]); w.w = cvt_pk_bf16(o1[2], o1[3]); gst<u32x4>(bu + bj * HALF, lo * 2u, w); } }
            }
        }
    }
};
template <int MODE> struct EpiBf16 { static constexpr bool PERM = true, APERM = false;
    GAS bf16_t* O; float scale; const GAS float* corr;
    __device__ __forceinline__ void operator()(f32x4 (&acc)[2][2][4][2], const Unit& u, int wr, int wc, int lane) const {
        const int fr = lane & 15, fq = lane >> 4;
        size_t base; constexpr unsigned ldc = MODE == 0 ? DM : 4096;
        if (MODE == 0) { base = (size_t)(u.pm * BM) * DM + u.pn * BM; }
        else { const int g = u.pm >> 1, part = u.pm & 1, b = u.pn >> 3, st = u.pn & 7; base = ((size_t)b * 1024 + g * 256) * 4096 + (size_t)part * 2048 + st * 256; }
        GAS bf16_t* ou = O + base + (size_t)(wr * 64) * ldc + wc * 32;
        f32x4 cv[2][2];
#pragma unroll
        for (int bj = 0; bj < 2; ++bj)
#pragma unroll
            for (int n = 0; n < 2; ++n) { cv[bj][n] = (f32x4){0.f, 0.f, 0.f, 0.f};
                if (MODE == 0) { cv[bj][n] = gld<f32x4>(corr + (size_t)(u.pm >> 4) * 1024 + u.pn * BM + bj * HALF + wc * 32 + 4 * n, 32u * fq); if (fr & 1) cv[bj][n] = -cv[bj][n]; } }
#pragma unroll
        for (int ai = 0; ai < 2; ++ai)
#pragma unroll
            for (int m = 0; m < 4; ++m) { const unsigned lo = ((unsigned)(fr + ai * HALF + m * 16) * ldc + 8u * fq) * 2u;
#pragma unroll
                for (int bj = 0; bj < 2; ++bj) { const f32x4 v0 = (acc[ai][bj][m][0] + cv[bj][0]) * scale, v1 = (acc[ai][bj][m][1] + cv[bj][1]) * scale;
                    u32x4 w; w.x = cvt_pk_bf16(v0[0], v0[1]); w.y = cvt_pk_bf16(v0[2], v0[3]); w.z = cvt_pk_bf16(v1[0], v1[1]); w.w = cvt_pk_bf16(v1[2], v1[3]);
                    gst<u32x4>(ou + bj * HALF, lo, w); } }
    }
};
struct EpiF2s { static constexpr bool PERM = true, APERM = false;
    GAS bf16_t* Z; float scale; const GAS float* corr; GAS float* PS;
    __device__ __forceinline__ void operator()(f32x4 (&acc)[2][2][4][2], const Unit& u, int wr, int wc, int lane) const {
        const int fr = lane & 15, fq = lane >> 4;
        const int b = u.pm >> 4, part = (u.pm >> 3) & 1, kt = u.pm & 7;
        GAS float* ps = PS + (size_t)blockIdx.x * (32 * 512 * 4);
        const unsigned lops = (unsigned)((wr * 4 + wc) * 64 + lane) * 16u;
        if (part == 0) {
#pragma unroll
            for (int ai = 0; ai < 2; ++ai)
#pragma unroll
                for (int bj = 0; bj < 2; ++bj)
#pragma unroll
                    for (int m = 0; m < 4; ++m)
#pragma unroll
                        for (int n = 0; n < 2; ++n) gst<f32x4>(ps + (((ai * 2 + bj) * 4 + m) * 2 + n) * 2048, lops, acc[ai][bj][m][n]);
            return;
        }
        asm volatile("s_waitcnt vmcnt(0)" ::: "memory");
        f32x4 cv[2][2];
#pragma unroll
        for (int bj = 0; bj < 2; ++bj)
#pragma unroll
            for (int n = 0; n < 2; ++n) { cv[bj][n] = gld<f32x4>(corr + (size_t)b * 1024 + u.pn * BM + bj * HALF + wc * 32 + 4 * n, 32u * fq); if (fr & 1) cv[bj][n] = -cv[bj][n]; }
        GAS bf16_t* zu = Z + (size_t)b * SEQ * DM + u.pn * BM + wc * 32;
#pragma unroll
        for (int ai = 0; ai < 2; ++ai)
#pragma unroll
            for (int m = 0; m < 4; ++m) {
                const int k = kt * 256 + ai * HALF + wr * 64 + m * 16 + fr;
                const unsigned lo1 = ((unsigned)k * DM + 8u * fq) * 2u, lo2 = ((unsigned)(SEQ - k) * DM + 8u * fq) * 2u;
#pragma unroll
                for (int bj = 0; bj < 2; ++bj) {
                    const f32x4 c0 = gld<f32x4>(ps + (((ai * 2 + bj) * 4 + m) * 2 + 0) * 2048, lops) + cv[bj][0], c1 = gld<f32x4>(ps + (((ai * 2 + bj) * 4 + m) * 2 + 1) * 2048, lops) + cv[bj][1];
                    const f32x4 s0 = acc[ai][bj][m][0], s1 = acc[ai][bj][m][1];
                    const f32x4 p0 = (c0 + s0) * scale, p1 = (c1 + s1) * scale, q0 = (c0 - s0) * scale, q1 = (c1 - s1) * scale;
                    u32x4 w; w.x = cvt_pk_bf16(p0[0], p0[1]); w.y = cvt_pk_bf16(p0[2], p0[3]); w.z = cvt_pk_bf16(p1[0], p1[1]); w.w = cvt_pk_bf16(p1[2], p1[3]);
                    gst<u32x4>(zu + bj * HALF, lo1, w);
                    if (k != 0) { u32x4 v; v.x = cvt_pk_bf16(q0[0], q0[1]); v.y = cvt_pk_bf16(q0[2], q0[3]); v.z = cvt_pk_bf16(q1[0], q1[1]); v.w = cvt_pk_bf16(q1[2], q1[3]);
                        gst<u32x4>(zu + bj * HALF, lo2, v); }
                }
            }
    }
};
struct EpiQkvGqa { static constexpr bool PERM = true, APERM = false;
    GAS bf16_t* O; const GAS float* qg; const GAS float* kg; const GAS float* axc; const GAS float* axs;
    __device__ __forceinline__ void operator()(f32x4 (&acc)[2][2][4][2], const Unit& u, int wr, int wc, int lane) const {
        const int fr = lane & 15, fq = lane >> 4;
        const bool isv = u.pn == 5, isq = u.pn < 4;
        const GAS float* gp = isq ? qg : kg;
        const int dl = 32 * (fq >> 1) + 8 * (fq & 1);
        f32x4 gv[2][2];
#pragma unroll
        for (int bj = 0; bj < 2; ++bj)
#pragma unroll
            for (int n = 0; n < 2; ++n) gv[bj][n] = gld<f32x4>(gp + 16 * bj + 4 * n, 4u * dl);
        const float osc = isq ? C2 : 1.0f;
#pragma unroll
        for (int ai = 0; ai < 2; ++ai) {
            const int rowu = u.pm * BM + ai * HALF + wr * 64;
            GAS bf16_t* ou = O + (size_t)rowu * 1536 + u.pn * 256 + wc * 64;
#pragma unroll
            for (int m = 0; m < 4; ++m) {
                const unsigned lo = ((unsigned)(m * 16 + fr) * 1536u + (unsigned)dl) * 2u;
                f32x4 v[2][2];
#pragma unroll
                for (int bj = 0; bj < 2; ++bj)
#pragma unroll
                    for (int n = 0; n < 2; ++n) v[bj][n] = acc[ai][bj][m][n];
                if (!isv) {
                    float ss = 0.f;
#pragma unroll
                    for (int bj = 0; bj < 2; ++bj)
#pragma unroll
                        for (int n = 0; n < 2; ++n) ss += (v[bj][n][0] * v[bj][n][0] + v[bj][n][1] * v[bj][n][1]) + (v[bj][n][2] * v[bj][n][2] + v[bj][n][3] * v[bj][n][3]);
                    ss = xsum32(xsum16(ss));
                    const float rinv = 1.0f / sqrtf(ss * (1.0f / 64.0f) + RMS_EPS);
                    const int s = (rowu + m * 16 + fr) & (SEQ - 1);
                    const int t = (fq >> 1) == 0 ? (s >> 6) : (s & 63);
#pragma unroll
                    for (int n = 0; n < 2; ++n) {
                        const unsigned to = (unsigned)(t * 16 + 8 * (fq & 1) + 4 * n) * 4u;
                        const f32x4 c = gld<f32x4>(axc, to), sn = gld<f32x4>(axs, to);
                        const f32x4 x1 = v[0][n] * rinv * gv[0][n], x2 = v[1][n] * rinv * gv[1][n];
                        v[0][n] = (x1 * c - x2 * sn) * osc; v[1][n] = (x2 * c + x1 * sn) * osc;
                    }
                }
#pragma unroll
                for (int bj = 0; bj < 2; ++bj) { u32x4 w; w.x = cvt_pk_bf16(v[bj][0][0], v[bj][0][1]); w.y = cvt_pk_bf16(v[bj][0][2], v[bj][0][3]); w.z = cvt_pk_bf16(v[bj][1][0], v[bj][1][1]); w.w = cvt_pk_bf16(v[bj][1][2], v[bj][1][3]);
                    gst<u32x4>(ou + 16 * bj, lo, w); }
            }
        }
    }
};
struct EpiQkvDiff { static constexpr bool PERM = true, APERM = false;
    GAS bf16_t* O; const GAS float* rc; const GAS float* rs;
    __device__ __forceinline__ void operator()(f32x4 (&acc)[2][2][4][2], const Unit& u, int wr, int wc, int lane) const {
        const int fr = lane & 15, fq = lane >> 4;
        const bool ropesel = (u.pn < 8) && ((wc & 1) == 0);
        const bool rope = ropesel && (fq < 2);
        const float osc = (u.pn < 4) ? C2 : 1.0f;
#pragma unroll
        for (int ai = 0; ai < 2; ++ai) {
            const int rowu = u.pm * BM + ai * HALF + wr * 64;
            GAS bf16_t* ou = O + (size_t)rowu * 3072 + u.pn * BM + wc * 32;
#pragma unroll
            for (int m = 0; m < 4; ++m) {
                const unsigned lo = ((unsigned)(m * 16 + fr) * 3072u + 8u * fq) * 2u;
                const int s = (rowu + m * 16 + fr) & (SEQ - 1);
#pragma unroll
                for (int bj = 0; bj < 2; ++bj) {
                    f32x4 v0 = acc[ai][bj][m][0], v1 = acc[ai][bj][m][1];
                    if (ropesel) {
                        f32x4 p0, p1;
#pragma unroll
                        for (int j = 0; j < 4; ++j) { p0[j] = xpart16(v0[j], (fq & 1) != 0); p1[j] = xpart16(v1[j], (fq & 1) != 0); }
                        if (rope) {
                            const f32x4 ca = gld<f32x4>(rc, (unsigned)s * 32u), cb = gld<f32x4>(rc + 4, (unsigned)s * 32u), sa = gld<f32x4>(rs, (unsigned)s * 32u), sb = gld<f32x4>(rs + 4, (unsigned)s * 32u);
                            if (fq == 0) { v0 = v0 * ca - p0 * sa; v1 = v1 * cb - p1 * sb; }
                            else { v0 = v0 * ca + p0 * sa; v1 = v1 * cb + p1 * sb; }
                        }
                    }
                    v0 = v0 * osc; v1 = v1 * osc;
                    u32x4 w; w.x = cvt_pk_bf16(v0[0], v0[1]); w.y = cvt_pk_bf16(v0[2], v0[3]); w.z = cvt_pk_bf16(v1[0], v1[1]); w.w = cvt_pk_bf16(v1[2], v1[3]);
                    gst<u32x4>(ou + bj * HALF, lo, w);
                }
            }
        }
    }
};
__device__ __forceinline__ float dpp_ror1(float x) { return __builtin_bit_cast(float, __builtin_amdgcn_mov_dpp(__builtin_bit_cast(int, x), 0x121, 0xf, 0xf, true)); }
__device__ __forceinline__ float dpp_ror15(float x) { return __builtin_bit_cast(float, __builtin_amdgcn_mov_dpp(__builtin_bit_cast(int, x), 0x12F, 0xf, 0xf, true)); }
__device__ __forceinline__ float silu_mul(float g, float v) { return g * v * __builtin_amdgcn_rcpf(1.0f + __builtin_amdgcn_exp2f(-1.4426950408889634f * g)); }
struct EpiUpConv { static constexpr bool PERM = true, APERM = true;
    GAS bf16_t* G; GAS bf16_t* E; const GAS float* cw; const GAS float* cb;
    __device__ __forceinline__ void conv4(const f32x4& a0, const f32x4& a1, const f32x4& a2, const f32x4& a3, const f32x4& w0, const f32x4& w1, const f32x4& w2, const f32x4& b, f32x2 (&h)[4][2]) const {
#pragma unroll
        for (int p = 0; p < 2; ++p) {
            float u0, u1, d0, d1;
            asm volatile("s_nop 1\n\tv_mov_b32_dpp %0, %1 row_shr:1 row_mask:0xf bank_mask:0xf bound_ctrl:1" : "=&v"(u0) : "v"(a3[2 * p]));
            asm volatile("s_nop 1\n\tv_mov_b32_dpp %0, %1 row_shr:1 row_mask:0xf bank_mask:0xf bound_ctrl:1" : "=&v"(u1) : "v"(a3[2 * p + 1]));
            asm volatile("s_nop 1\n\tv_mov_b32_dpp %0, %1 row_shl:1 row_mask:0xf bank_mask:0xf bound_ctrl:1" : "=&v"(d0) : "v"(a0[2 * p]));
            asm volatile("s_nop 1\n\tv_mov_b32_dpp %0, %1 row_shl:1 row_mask:0xf bank_mask:0xf bound_ctrl:1" : "=&v"(d1) : "v"(a0[2 * p + 1]));
            const f32x2 UP = {u0, u1}, DN = {d0, d1};
            const f32x2 A0 = {a0[2 * p], a0[2 * p + 1]}, A1 = {a1[2 * p], a1[2 * p + 1]}, A2 = {a2[2 * p], a2[2 * p + 1]}, A3 = {a3[2 * p], a3[2 * p + 1]};
            const f32x2 W0 = {w0[2 * p], w0[2 * p + 1]}, W1 = {w1[2 * p], w1[2 * p + 1]}, W2 = {w2[2 * p], w2[2 * p + 1]}, B = {b[2 * p], b[2 * p + 1]};
            h[0][p] = B + W0 * UP + W1 * A0 + W2 * A1;
            h[1][p] = B + W0 * A0 + W1 * A1 + W2 * A2;
            h[2][p] = B + W0 * A1 + W1 * A2 + W2 * A3;
            h[3][p] = B + W0 * A2 + W1 * A3 + W2 * DN;
        }
    }
    static __device__ __forceinline__ unsigned silu_pk(const f32x2 g, const f32x2 v) {
        const f32x2 t = g * -1.4426950408889634f;
        const f32x2 d = (f32x2){__builtin_amdgcn_exp2f(t.x), __builtin_amdgcn_exp2f(t.y)} + 1.0f;
        const f32x2 o = g * v * (f32x2){__builtin_amdgcn_rcpf(d.x), __builtin_amdgcn_rcpf(d.y)};
        return cvt_pk_bf16(o.x, o.y);
    }
    __device__ __forceinline__ void operator()(f32x4 (&acc)[2][2][4][2], const Unit& u, int wr, int wc, int lane) const {
        const int fr = lane & 15, fq = lane >> 4;
        const int colu = u.pn * 128 + wc * 32;
        const GAS float* cwu = cw + colu; const GAS float* cbu = cb + colu;
        u32x2 keep[2][4];
        u32x2 ekeep[2][2][2];
        f32x4 wgt[2][8];
#pragma unroll
        for (int n = 0; n < 2; ++n) { const unsigned co = (unsigned)(8 * fq + 4 * n) * 4u;
            wgt[n][0] = gld<f32x4>(cwu, co); wgt[n][1] = gld<f32x4>(cwu + NUP, co); wgt[n][2] = gld<f32x4>(cwu + 2 * NUP, co); wgt[n][3] = gld<f32x4>(cbu, co);
            wgt[n][4] = gld<f32x4>(cwu + DFF, co); wgt[n][5] = gld<f32x4>(cwu + NUP + DFF, co); wgt[n][6] = gld<f32x4>(cwu + 2 * NUP + DFF, co); wgt[n][7] = gld<f32x4>(cbu + DFF, co); }
#pragma unroll
        for (int n = 0; n < 2; ++n) {
            const f32x4 wg0 = wgt[n][0], wg1 = wgt[n][1], wg2 = wgt[n][2], bg = wgt[n][3], wv0 = wgt[n][4], wv1 = wgt[n][5], wv2 = wgt[n][6], bvv = wgt[n][7];
#pragma unroll
            for (int ai = 0; ai < 2; ++ai) {
                const int blk = 4 * u.pm + 2 * ai + wr;
                GAS bf16_t* gu = G + (size_t)(u.pm * BM + ai * HALF + wr * 64) * DFF + colu;
                GAS bf16_t* eu = E + (size_t)blk * 4 * NUP + colu;
                f32x2 hg[4][2], hv[4][2];
                conv4(acc[ai][0][0][n], acc[ai][0][1][n], acc[ai][0][2][n], acc[ai][0][3][n], wg0, wg1, wg2, bg, hg);
                conv4(acc[ai][1][0][n], acc[ai][1][1][n], acc[ai][1][2][n], acc[ai][1][3][n], wv0, wv1, wv2, bvv, hv);
#pragma unroll
                for (int m = 0; m < 4; ++m) {
                    u32x2 w; w.x = silu_pk(hg[m][0], hv[m][0]); w.y = silu_pk(hg[m][1], hv[m][1]);
                    if (n == 0) keep[ai][m] = w;
                    else { u32x4 w4; w4.x = keep[ai][m].x; w4.y = keep[ai][m].y; w4.z = w.x; w4.w = w.y; gst<u32x4>(gu, ((unsigned)(4 * fr + m) * DFF + 8u * fq) * 2u, w4); }
                }
                if (fr == 0 || fr == 15) {
                    const int mb = fr == 0 ? 0 : 2;
#pragma unroll
                    for (int e = 0; e < 2; ++e) {
                        const f32x4 eg = fr == 0 ? acc[ai][0][e][n] : acc[ai][0][2 + e][n], ev = fr == 0 ? acc[ai][1][e][n] : acc[ai][1][2 + e][n];
                        const u32x2 pg = (u32x2){cvt_pk_f16(eg[0], eg[1]), cvt_pk_f16(eg[2], eg[3])}, pv = (u32x2){cvt_pk_f16(ev[0], ev[1]), cvt_pk_f16(ev[2], ev[3])};
                        if (n == 0) { ekeep[ai][e][0] = pg; ekeep[ai][e][1] = pv; }
                        else { const unsigned eo = ((unsigned)(mb + e) * NUP + 8u * fq) * 2u;
                            gst<u32x4>(eu, eo, (u32x4){ekeep[ai][e][0].x, ekeep[ai][e][0].y, pg.x, pg.y}); gst<u32x4>(eu + DFF, eo, (u32x4){ekeep[ai][e][1].x, ekeep[ai][e][1].y, pv.x, pv.y}); }
                    }
                }
            }
        }
    }
};

template <class Epi, class Map, bool ALIGN_EPI>
__device__ __forceinline__ void gemm_phase(const int tid, LAS unsigned char* lds, const int lda, const int ldb, const int K, const Map& MP, const StaticOrder& S, const Epi& E) {
    const int wid = __builtin_amdgcn_readfirstlane(tid >> 6), lane = tid & 63, wr = wid >> 2, wc = wid & 3, fr = lane & 15, fq = lane >> 4;
    const int nt = K / BK;
    unsigned voA, voB;
    { int R, C; stage_rc(tid * 16, R, C); const int Rb = Epi::PERM ? ((R & ~31) + perm32(R & 31)) : R;
      const int Ra = Epi::APERM ? ((R & ~63) + 4 * (R & 15) + ((R >> 4) & 3)) : R;
      voA = (unsigned)(Ra * lda + C) * 2u; voB = (unsigned)(Rb * ldb + C) * 2u; }
    const size_t r64A = (size_t)64 * lda * 2, r64B = (size_t)64 * ldb * 2;
    const size_t kstep = (size_t)(BK * 2);
    const size_t hstepA = (size_t)HALF * lda * 2, hstepB = (size_t)HALF * ldb * 2;
    const unsigned ldsw = (unsigned)wid * 1024u;
    const int aoff = lds_byte(wr * 64 + fr, fq * 8), boff = lds_byte(wc * 32 + fr, fq * 8);
#define PG8_SA(b, h) (((b) * 2 + (h)) * HTB)
#define PG8_SB(b, h) ((4 + (b) * 2 + (h)) * HTB)
#define PG8_STAGE(bufoff, gbase, voff) do { _Pragma("unroll") for (int _i = 0; _i < 2; ++_i) \
        __builtin_amdgcn_global_load_lds((const GAS unsigned*)((const GAS char*)(gbase) + (size_t)_i * r64##voff + (vo##voff)), (LAS unsigned*)(lds + (bufoff) + ldsw + _i * 8192), 16, 0, 0); } while (0)
#define PG8_LDA(dst, b, h) do { _Pragma("unroll") for (int m = 0; m < 4; ++m) _Pragma("unroll") for (int k = 0; k < 2; ++k) dst[m][k] = *(const LAS bf16x8*)(lds + PG8_SA(b, h) + aoff + m * 2048 + k * 1024); } while (0)
#define PG8_LDB(dst, b, h) do { _Pragma("unroll") for (int n = 0; n < 2; ++n) _Pragma("unroll") for (int k = 0; k < 2; ++k) dst[n][k] = *(const LAS bf16x8*)(lds + PG8_SB(b, h) + boff + n * 2048 + k * 1024); } while (0)
#define PG8_MMA(ai, bj, At, Bt) do { __builtin_amdgcn_s_setprio(1); _Pragma("unroll") for (int m = 0; m < 4; ++m) _Pragma("unroll") for (int n = 0; n < 2; ++n) _Pragma("unroll") for (int k = 0; k < 2; ++k) \
        acc[ai][bj][m][n] = __builtin_amdgcn_mfma_f32_16x16x32_bf16(Bt[n][k], At[m][k], acc[ai][bj][m][n], 0, 0, 0); __builtin_amdgcn_s_setprio(0); } while (0)
#define PG8_WAIT_V(n) asm volatile("s_waitcnt vmcnt(" #n ")" ::: "memory")
#define PG8_WAIT_L(n) asm volatile("s_waitcnt lgkmcnt(" #n ")" ::: "memory")
#define PG8_BAR __builtin_amdgcn_s_barrier()
#define PG8_SCHED __builtin_amdgcn_sched_barrier(0)
    Unit cur, nxt; int ui = 0;
    if (!S.next(0, cur)) return;
    f32x4 acc[2][2][4][2];
#pragma unroll
    for (int a = 0; a < 2; ++a)
#pragma unroll
        for (int b = 0; b < 2; ++b)
#pragma unroll
            for (int m = 0; m < 4; ++m)
#pragma unroll
                for (int n = 0; n < 2; ++n) acc[a][b][m][n] = (f32x4){0.f, 0.f, 0.f, 0.f};
    bf16x8 At[4][2], B0[2][2], B1[2][2];
    const char* cA; const char* cB; MP.ptrs(cur, cA, cB);
    PG8_STAGE(PG8_SB(0, 0), cB, B); PG8_STAGE(PG8_SB(0, 1), cB + hstepB, B); PG8_STAGE(PG8_SA(0, 0), cA, A); PG8_STAGE(PG8_SA(0, 1), cA + hstepA, A);
    if (wr == 1) PG8_BAR;
    PG8_WAIT_V(2); PG8_BAR;
    PG8_STAGE(PG8_SB(1, 0), cB + kstep, B); PG8_STAGE(PG8_SA(1, 0), cA + kstep, A); PG8_STAGE(PG8_SB(1, 1), cB + hstepB + kstep, B);
    PG8_WAIT_V(6); PG8_BAR;
    for (;;) {
        const bool has_next = S.next(ui + 1, nxt);
        const char* nA = cA; const char* nB = cB; if (has_next) MP.ptrs(nxt, nA, nB);
        for (int t = 0; t < nt; t += 2) {
            const bool last = (t == nt - 2);
            const char* a1 = cA + (size_t)(t + 1) * kstep;
            const char* a2 = last ? nA : cA + (size_t)(t + 2) * kstep; const char* b2 = last ? nB : cB + (size_t)(t + 2) * kstep;
            const char* a3 = a2 + kstep; const char* b3 = b2 + kstep;
            PG8_LDB(B0, 0, 0); PG8_LDB(B1, 0, 1); PG8_SCHED; PG8_LDA(At, 0, 0); PG8_STAGE(PG8_SA(1, 1), a1 + hstepA, A);
            PG8_WAIT_V(8); PG8_WAIT_L(0); PG8_BAR; PG8_MMA(0, 0, At, B0); PG8_MMA(0, 1, At, B1); PG8_BAR; PG8_SCHED;
            PG8_LDA(At, 0, 1); PG8_STAGE(PG8_SB(0, 0), b2, B); PG8_STAGE(PG8_SB(0, 1), b2 + hstepB, B); PG8_STAGE(PG8_SA(0, 0), a2, A);
            PG8_WAIT_V(8); PG8_WAIT_L(0); PG8_BAR; PG8_MMA(1, 0, At, B0); PG8_MMA(1, 1, At, B1); PG8_BAR; PG8_SCHED;
            PG8_LDB(B0, 1, 0); PG8_LDB(B1, 1, 1); PG8_SCHED; PG8_LDA(At, 1, 0); PG8_STAGE(PG8_SA(0, 1), a2 + hstepA, A);
            PG8_WAIT_V(8); PG8_WAIT_L(0); PG8_BAR; PG8_MMA(0, 0, At, B0); PG8_MMA(0, 1, At, B1); PG8_BAR; PG8_SCHED;
            PG8_LDA(At, 1, 1); PG8_STAGE(PG8_SB(1, 0), b3, B); PG8_STAGE(PG8_SB(1, 1), b3 + hstepB, B); PG8_STAGE(PG8_SA(1, 0), a3, A);
            PG8_WAIT_V(8); PG8_WAIT_L(0); PG8_BAR; PG8_MMA(1, 0, At, B0); PG8_MMA(1, 1, At, B1); PG8_BAR; PG8_SCHED;
        }
        if constexpr (ALIGN_EPI) { if (wr == 0) PG8_BAR; }
        { int ln_; asm volatile("v_mbcnt_lo_u32_b32 %0, -1, 0\n\tv_mbcnt_hi_u32_b32 %0, -1, %0" : "=v"(ln_)); E(acc, cur, wr, wc, ln_); }
        if (!has_next) break;
#pragma unroll
        for (int a = 0; a < 2; ++a)
#pragma unroll
            for (int b = 0; b < 2; ++b)
#pragma unroll
                for (int m = 0; m < 4; ++m)
#pragma unroll
                    for (int n = 0; n < 2; ++n) acc[a][b][m][n] = (f32x4){0.f, 0.f, 0.f, 0.f};
        cur = nxt; cA = nA; cB = nB; ++ui;
        if constexpr (ALIGN_EPI) { if (wr == 1) PG8_BAR; }
    }
    PG8_WAIT_V(0);
    if constexpr (!ALIGN_EPI) { if (wr == 0) PG8_BAR; }
    PG8_BAR;
#undef PG8_SA
#undef PG8_SB
#undef PG8_STAGE
#undef PG8_LDA
#undef PG8_LDB
#undef PG8_MMA
#undef PG8_WAIT_V
#undef PG8_WAIT_L
#undef PG8_BAR
#undef PG8_SCHED
}
}

namespace attn_body {
using bf16 = __hip_bfloat16;
using s16x4 = __attribute__((ext_vector_type(4))) short;
using f32x16 = __attribute__((ext_vector_type(16))) float;
constexpr int D = 64, NW = 8, QBLK = 32, QB = QBLK * NW, KVBLK = 64;
__device__ __forceinline__ int crow(int r, int hi) { return (r & 3) + 8 * (r >> 2) + 4 * hi; }
#define SBAR() __builtin_amdgcn_sched_barrier(0)
constexpr int NSLOT = 3, SLOTB = 8192;
constexpr int LDS_K = 0, LDS_V = NSLOT * SLOTB;
__device__ __forceinline__ void glds16(const void* ubase, unsigned voff, unsigned lds_dst) { unsigned keep;
  asm volatile("s_mov_b32 %0, m0\n\ts_mov_b32 m0, %3\n\ts_nop 0\n\tglobal_load_lds_dwordx4 %1, %2\n\ts_mov_b32 m0, %0" : "=&s"(keep) : "v"(voff), "s"(ubase), "s"(lds_dst) : "memory"); }
__device__ __forceinline__ float max3f(float a, float b, float c) { float r; asm("v_max3_f32 %0, %1, %2, %3" : "=v"(r) : "v"(a), "v"(b), "v"(c)); return r; }
__device__ __forceinline__ float max2f(float a, float b) { float r; asm("v_max_f32_e32 %0, %1, %2" : "=v"(r) : "v"(a), "v"(b)); return r; }
__device__ __forceinline__ float fadd_s(float a, float b) { float r; asm("v_add_f32_e32 %0, %1, %2" : "=v"(r) : "v"(a), "v"(b)); return r; }
__device__ __forceinline__ float fsub_s(float a, float b) { float r; asm("v_sub_f32_e32 %0, %1, %2" : "=v"(r) : "v"(a), "v"(b)); return r; }
typedef float f32x2_t __attribute__((ext_vector_type(2))); typedef __bf16 bf16x2_t __attribute__((ext_vector_type(2)));
__device__ __forceinline__ unsigned cvtpk_s(float lo, float hi) { f32x2_t v = {lo, hi}; bf16x2_t b = __builtin_convertvector(v, bf16x2_t); return __builtin_bit_cast(unsigned, b); }
#define WAIT_BAR(N) asm volatile("s_waitcnt vmcnt(" #N ") lgkmcnt(0)\n\ts_barrier" ::: "memory")

__device__ __forceinline__ void qkt(f32x16& p0, f32x16& p1, const char* Kslot, const bf16x8* qr, const f32x16& negm, int r32, int hi) {
  const char* kb = Kslot + hi * 1024 + r32 * 16;
  #pragma unroll
  for (int d0 = 0; d0 < 4; ++d0) {
    const bf16x8 b0 = *reinterpret_cast<const bf16x8*>(kb + d0 * 2048);
    const bf16x8 b1 = *reinterpret_cast<const bf16x8*>(kb + d0 * 2048 + 512);
    if (d0 == 0) { p0 = __builtin_amdgcn_mfma_f32_32x32x16_bf16(b0, qr[0], negm, 0, 0, 0); p1 = __builtin_amdgcn_mfma_f32_32x32x16_bf16(b1, qr[0], negm, 0, 0, 0); }
    else { p0 = __builtin_amdgcn_mfma_f32_32x32x16_bf16(b0, qr[d0], p0, 0, 0, 0); p1 = __builtin_amdgcn_mfma_f32_32x32x16_bf16(b1, qr[d0], p1, 0, 0, 0); } }
}
typedef __attribute__((address_space(3))) const char* lds_cptr;
typedef short v4i16_t __attribute__((ext_vector_type(4)));
__device__ __forceinline__ void kload8(bf16x8* kf, lds_cptr kp) {
  kf[0] = *(const __attribute__((address_space(3))) bf16x8*)(kp);        kf[1] = *(const __attribute__((address_space(3))) bf16x8*)(kp + 512);
  kf[2] = *(const __attribute__((address_space(3))) bf16x8*)(kp + 2048); kf[3] = *(const __attribute__((address_space(3))) bf16x8*)(kp + 2560);
  kf[4] = *(const __attribute__((address_space(3))) bf16x8*)(kp + 4096); kf[5] = *(const __attribute__((address_space(3))) bf16x8*)(kp + 4608);
  kf[6] = *(const __attribute__((address_space(3))) bf16x8*)(kp + 6144); kf[7] = *(const __attribute__((address_space(3))) bf16x8*)(kp + 6656);
}
__device__ __forceinline__ void kload2(bf16x8* kf, lds_cptr kp, int j) { kf[2 * j] = *(const __attribute__((address_space(3))) bf16x8*)(kp + j * 2048); kf[2 * j + 1] = *(const __attribute__((address_space(3))) bf16x8*)(kp + j * 2048 + 512); }
__device__ __forceinline__ s16x4 vtr(lds_cptr p) { return __builtin_bit_cast(s16x4, __builtin_amdgcn_ds_read_tr16_b64_v4i16((__attribute__((address_space(3))) v4i16_t*)p)); }
__device__ __forceinline__ float rowmax(const f32x16& p0, const f32x16& p1) {
  float a = max3f(p0[0], p0[1], p1[0]), b = max3f(p0[2], p0[3], p1[1]); a = max3f(a, p1[2], p1[3]);
  #pragma unroll
  for (int r = 4; r < 16; r += 4) { a = max3f(a, p0[r], p0[r + 1]); b = max3f(b, p0[r + 2], p0[r + 3]); a = max3f(a, p1[r], p1[r + 1]); b = max3f(b, p1[r + 2], p1[r + 3]); }
  const float m = max2f(a, b);
  auto rr = __builtin_amdgcn_permlane32_swap(__float_as_uint(m), __float_as_uint(m), false, false);
  return max2f(__uint_as_float(rr[0]), __uint_as_float(rr[1]));
}
__device__ __forceinline__ void pv(f32x16* o, int vb, bf16x8 pa0, bf16x8 pa1, bf16x8 pa2, bf16x8 pa3) {
  #pragma unroll
  for (int d0 = 0; d0 < 2; ++d0) { s16x4 lo[4], hi[4];
    #pragma unroll
    for (int ks = 0; ks < 4; ++ks) {
      asm volatile("ds_read_b64_tr_b16 %0,%1 offset:%c2" : "=&v"(lo[ks]) : "v"(vb), "i"(d0 * 4096 + ks * 1024) : "memory");
      asm volatile("ds_read_b64_tr_b16 %0,%1 offset:%c2" : "=&v"(hi[ks]) : "v"(vb), "i"(d0 * 4096 + ks * 1024 + 512) : "memory"); }
    asm volatile("s_waitcnt lgkmcnt(0)" ::: "memory"); SBAR();
    #define PK(k) (bf16x8){lo[k][0], lo[k][1], lo[k][2], lo[k][3], hi[k][0], hi[k][1], hi[k][2], hi[k][3]}
    o[d0] = __builtin_amdgcn_mfma_f32_32x32x16_bf16(pa0, PK(0), o[d0], 0, 0, 0);
    o[d0] = __builtin_amdgcn_mfma_f32_32x32x16_bf16(pa1, PK(1), o[d0], 0, 0, 0);
    o[d0] = __builtin_amdgcn_mfma_f32_32x32x16_bf16(pa2, PK(2), o[d0], 0, 0, 0);
    o[d0] = __builtin_amdgcn_mfma_f32_32x32x16_bf16(pa3, PK(3), o[d0], 0, 0, 0);
    #undef PK
  }
}
template <int THRL, int KP, int DV2, bool NOMAX = false> __device__ __forceinline__ void attn_unit(int q0, const bf16* Qh, const bf16* __restrict__ Kh, const bf16* __restrict__ Vh, bf16* Oh, char* shm, const int tid, const bool comb = false, const float lam = 0.f, const float* subln = nullptr) {
  constexpr int OP = 1024, NT = 64;
  constexpr int LDS_WS = LDS_V + DV2 * NSLOT * SLOTB, LDS_OST = LDS_WS + NW * 64 * 4;
  const int lane = tid & 63, r32 = lane & 31, hi = lane >> 5; const int wid = __builtin_amdgcn_readfirstlane(tid >> 6);
  const bf16* Qw = Qh + (long)(q0 + wid * QBLK) * KP;
  const unsigned lds0 = (unsigned)(uintptr_t)shm;
  float* wsf = (float*)(shm + LDS_WS) + wid * 64;
  const bf16* ksrc = Kh + wid * 8; const unsigned kvo = (unsigned)(lane * KP) * 2u;
  const bf16* vsrc = Vh + (long)(16 * (wid & 3)) * KP + (wid >> 2) * 32; const unsigned vvo = (unsigned)((lane >> 2) * KP + (lane & 3) * 8) * 2u;
  const unsigned kdst = lds0 + LDS_K + wid * 1024, vdst = lds0 + LDS_V + wid * 1024;
  #define DMA_K(t, slot) glds16(ksrc + (long)(t) * KVBLK * KP, kvo, (unsigned)__builtin_amdgcn_readfirstlane(kdst + (slot)))
  #define DMA_V(t, slot) do { glds16(vsrc + (long)(t) * KVBLK * KP, vvo, (unsigned)__builtin_amdgcn_readfirstlane(vdst + DV2 * (slot))); \
    if constexpr (DV2 == 2) glds16(vsrc + 64 + (long)(t) * KVBLK * KP, vvo, (unsigned)__builtin_amdgcn_readfirstlane(vdst + DV2 * (slot) + 8192)); } while (0)
  const int vb0 = (int)(lds0 + LDS_V) + ((lane >> 4) & 1) * 32 + (lane & 3) * 8 + (4 * hi + ((lane & 15) >> 2)) * 64;
  const char* Kbase = shm + LDS_K; bf16x8 kf[8];
  const lds_cptr shm3 = (lds_cptr)shm; const lds_cptr kp0 = shm3 + LDS_K + hi * 1024 + r32 * 16; const lds_cptr vp0 = shm3 + LDS_V + ((lane >> 4) & 1) * 32 + (lane & 3) * 8 + (4 * hi + ((lane & 15) >> 2)) * 64;
  DMA_K(0, 0); DMA_V(0, 0); DMA_K(1, SLOTB);
  bf16x8 qr[4];
  #pragma unroll
  for (int d0 = 0; d0 < 4; ++d0) qr[d0] = *reinterpret_cast<const bf16x8*>(&Qw[(long)r32 * KP + d0 * 16 + hi * 8]);
  float z0 = 0.f; asm volatile("" : "+v"(z0)); float mhat = z0, l_reg = z0; f32x16 o[2 * DV2], negm;
  _Pragma("unroll") for (int r = 0; r < 16; ++r) { _Pragma("unroll") for (int d_ = 0; d_ < 2 * DV2; ++d_) o[d_][r] = z0; negm[r] = z0; } asm volatile("" : "+v"(negm));
  bool resc = false;
  #define START(P0, P1) do { resc = false; \
    if constexpr (!NOMAX) { const float rm = rowmax(P0, P1); const float dl = rm; mhat = fadd_s(mhat, dl); \
      _Pragma("unroll") for (int r = 0; r < 16; ++r) { P0[r] = fsub_s(P0[r], dl); P1[r] = fsub_s(P1[r], dl); } \
      _Pragma("unroll") for (int r = 0; r < 16; ++r) negm[r] = -mhat; asm volatile("" : "+v"(negm)); } \
    _Pragma("unroll") for (int r = 0; r < 16; ++r) P0[r] = __builtin_amdgcn_exp2f(P0[r]); } while (0)
  #define RESC() do { if constexpr (!NOMAX) if (resc) { asm volatile("s_waitcnt lgkmcnt(0)" ::: "memory"); \
      _Pragma("unroll") for (int d_ = 0; d_ < 2 * DV2; ++d_) _Pragma("unroll") for (int r = 0; r < 16; ++r) o[d_][r] *= wsf[crow(r, hi)]; } } while (0)
  f32x16 pA0, pA1, pB0, pB1;
  int sl_prev = 0, sl_cur = 0, sl_next = SLOTB;
  #define ROT() do { sl_prev = sl_cur; sl_cur = sl_next; sl_next = (sl_next == (NSLOT - 1) * SLOTB) ? 0 : sl_next + SLOTB; } while (0)
  DMA_K(2, 2 * SLOTB);
  if constexpr (DV2 == 2) { WAIT_BAR(4); } else { WAIT_BAR(3); }
  qkt(pA0, pA1, Kbase, qr, negm, r32, hi); asm volatile("s_nop 15\n\ts_nop 7" : "+v"(pA0), "+v"(pA1));
  START(pA0, pA1);
  _Pragma("unroll") for (int r = 0; r < 16; ++r) pA1[r] = __builtin_amdgcn_exp2f(pA1[r]);
  WAIT_BAR(0);
  DMA_K(3, 0); DMA_V(1, SLOTB);
  ROT();
  kload8(kf, kp0 + sl_cur);
  if constexpr (DV2 == 2) { WAIT_BAR(3); } else { WAIT_BAR(2); }
  s16x4 vlo[8], vhi[8]; u32x4 pw0, pw1, pw2, pw3;
  #define PKW(P, B) cvtpk_s(P[B], P[B + 1])
  #define PAF(k) __builtin_bit_cast(bf16x8, pw##k)
  #define VFR(i) (bf16x8){vlo[i][0], vlo[i][1], vlo[i][2], vlo[i][3], vhi[i][0], vhi[i][1], vhi[i][2], vhi[i][3]}
  #define PIN(x) asm volatile("" : "+v"(x))
  #define MX3(a, b, c) __builtin_fmaxf(__builtin_fmaxf((a), (b)), (c))
  #define GAPA(MF, A0, A1, A2, A3, W0, W1, PW) do { MF; sacc += A0; sacc += A1; sacc += A2; sacc += A3; PIN(sacc); W0; W1; PIN(PW); SBAR(); } while (0)
  #define EX(v) __builtin_amdgcn_exp2f(v)
  #define GAPB(MF, X, B) do { MF; X[B] = EX(X[B]); X[B + 1] = EX(X[B + 1]); X[B + 2] = EX(X[B + 2]); X[B + 3] = EX(X[B + 3]); PIN(X); SBAR(); } while (0)
  #define VRD(i) do { vlo[i] = vtr(vp_ + (((i) >> 2) * 4096 + ((i) & 3) * 1024)); vhi[i] = vtr(vp_ + (((i) >> 2) * 4096 + ((i) & 3) * 1024 + 512)); } while (0)
  #define VRD2(i) do { if constexpr (DV2 == 2) { vlo[i] = vtr(vp_ + (8192 + ((i) >> 2) * 4096 + ((i) & 3) * 1024)); vhi[i] = vtr(vp_ + (8192 + ((i) >> 2) * 4096 + ((i) & 3) * 1024 + 512)); SBAR(); } } while (0)
  #define KRD(G, j) do { if (G) { kload2(kf, kp0 + sl_next, j); SBAR(); } } while (0)
  #define STEP(C0, C1, P0, P1, t, GK, GV, GL) do { SBAR(); \
    const lds_cptr vp_ = vp0 + DV2 * sl_prev; \
    VRD(0); SBAR(); float sacc = (P0[0] + P0[1]); \
    GAPA(C0 = __builtin_amdgcn_mfma_f32_32x32x16_bf16(kf[0], qr[0], negm, 0, 0, 0), P0[2], P0[3], P0[4], P0[5],     pw0[0] = PKW(P0, 0), pw0[1] = PKW(P0, 2), pw0); \
    VRD(4); SBAR(); GAPA(C1 = __builtin_amdgcn_mfma_f32_32x32x16_bf16(kf[1], qr[0], negm, 0, 0, 0), P0[6], P0[7], P0[8], P0[9],     pw0[2] = PKW(P0, 4), pw0[3] = PKW(P0, 6), pw0); \
    VRD(1); SBAR(); GAPA(C0 = __builtin_amdgcn_mfma_f32_32x32x16_bf16(kf[2], qr[1], C0, 0, 0, 0),   P0[10], P0[11], P0[12], P0[13], pw1[0] = PKW(P0, 8), pw1[1] = PKW(P0, 10), pw1); \
    VRD(5); SBAR(); GAPA(C1 = __builtin_amdgcn_mfma_f32_32x32x16_bf16(kf[3], qr[1], C1, 0, 0, 0),   P0[14], P0[15], P1[0], P1[1],   pw1[2] = PKW(P0, 12), pw1[3] = PKW(P0, 14), pw1); \
    VRD(2); SBAR(); GAPA(C0 = __builtin_amdgcn_mfma_f32_32x32x16_bf16(kf[4], qr[2], C0, 0, 0, 0),   P1[2], P1[3], P1[4], P1[5],     pw2[0] = PKW(P1, 0), pw2[1] = PKW(P1, 2), pw2); \
    VRD(6); SBAR(); GAPA(C1 = __builtin_amdgcn_mfma_f32_32x32x16_bf16(kf[5], qr[2], C1, 0, 0, 0),   P1[6], P1[7], P1[8], P1[9],     pw2[2] = PKW(P1, 4), pw2[3] = PKW(P1, 6), pw2); \
    VRD(3); SBAR(); GAPA(C0 = __builtin_amdgcn_mfma_f32_32x32x16_bf16(kf[6], qr[3], C0, 0, 0, 0),   P1[10], P1[11], P1[12], P1[13], pw3[0] = PKW(P1, 8), pw3[1] = PKW(P1, 10), pw3); \
    VRD(7); SBAR(); GAPA(C1 = __builtin_amdgcn_mfma_f32_32x32x16_bf16(kf[7], qr[3], C1, 0, 0, 0),   P1[14], P1[15], 0.f, 0.f,       pw3[2] = PKW(P1, 12), pw3[3] = PKW(P1, 14), pw3); \
    l_reg += sacc; \
    if (GK) { DMA_K((t) + 3, sl_cur); } if (GV) { DMA_V((t) + 1, sl_next); } \
    if constexpr (!NOMAX) { float a = MX3(C0[0], C0[1], C1[0]), b = MX3(C0[2], C0[3], C1[1]); a = MX3(a, C1[2], C1[3]); \
      _Pragma("unroll") for (int r = 4; r < 16; r += 4) { a = MX3(a, C0[r], C0[r + 1]); b = MX3(b, C0[r + 2], C0[r + 3]); a = MX3(a, C1[r], C1[r + 1]); b = MX3(b, C1[r + 2], C1[r + 3]); } \
      float rm = __builtin_fmaxf(a, b); { auto rr = __builtin_amdgcn_permlane32_swap(__float_as_uint(rm), __float_as_uint(rm), false, false); rm = __builtin_fmaxf(__uint_as_float(rr[0]), __uint_as_float(rr[1])); } \
      resc = false; \
      if (__builtin_expect(__any(rm > (float)THRL), 0)) { const float dl = __builtin_fmaxf(rm, 0.f); mhat += dl; \
        _Pragma("unroll") for (int r = 0; r < 16; ++r) { C0[r] -= dl; C1[r] -= dl; } \
        _Pragma("unroll") for (int r = 0; r < 16; ++r) negm[r] = -mhat; asm volatile("" : "+v"(negm)); \
        const float f = __builtin_amdgcn_exp2f(-dl); l_reg *= f; if (hi == 0) wsf[r32] = f; resc = true; } } \
    SBAR(); \
    GAPB(o[0] = __builtin_amdgcn_mfma_f32_32x32x16_bf16(PAF(0), VFR(0), o[0], 0, 0, 0), C0, 0); VRD2(0); \
    GAPB(o[1] = __builtin_amdgcn_mfma_f32_32x32x16_bf16(PAF(0), VFR(4), o[1], 0, 0, 0), C0, 4); VRD2(4); \
    KRD(GL, 0); GAPB(o[0] = __builtin_amdgcn_mfma_f32_32x32x16_bf16(PAF(1), VFR(1), o[0], 0, 0, 0), C0, 8); VRD2(1); \
    KRD(GL, 1); GAPB(o[1] = __builtin_amdgcn_mfma_f32_32x32x16_bf16(PAF(1), VFR(5), o[1], 0, 0, 0), C0, 12); VRD2(5); \
    KRD(GL, 2); GAPB(o[0] = __builtin_amdgcn_mfma_f32_32x32x16_bf16(PAF(2), VFR(2), o[0], 0, 0, 0), C1, 0); VRD2(2); \
    KRD(GL, 3); GAPB(o[1] = __builtin_amdgcn_mfma_f32_32x32x16_bf16(PAF(2), VFR(6), o[1], 0, 0, 0), C1, 4); VRD2(6); \
    GAPB(o[0] = __builtin_amdgcn_mfma_f32_32x32x16_bf16(PAF(3), VFR(3), o[0], 0, 0, 0), C1, 8); VRD2(3); \
    GAPB(o[1] = __builtin_amdgcn_mfma_f32_32x32x16_bf16(PAF(3), VFR(7), o[1], 0, 0, 0), C1, 12); VRD2(7); \
    if constexpr (DV2 == 2) { \
      o[2] = __builtin_amdgcn_mfma_f32_32x32x16_bf16(PAF(0), VFR(0), o[2], 0, 0, 0); o[3] = __builtin_amdgcn_mfma_f32_32x32x16_bf16(PAF(0), VFR(4), o[3], 0, 0, 0); \
      o[2] = __builtin_amdgcn_mfma_f32_32x32x16_bf16(PAF(1), VFR(1), o[2], 0, 0, 0); o[3] = __builtin_amdgcn_mfma_f32_32x32x16_bf16(PAF(1), VFR(5), o[3], 0, 0, 0); \
      o[2] = __builtin_amdgcn_mfma_f32_32x32x16_bf16(PAF(2), VFR(2), o[2], 0, 0, 0); o[3] = __builtin_amdgcn_mfma_f32_32x32x16_bf16(PAF(2), VFR(6), o[3], 0, 0, 0); \
      o[2] = __builtin_amdgcn_mfma_f32_32x32x16_bf16(PAF(3), VFR(3), o[2], 0, 0, 0); o[3] = __builtin_amdgcn_mfma_f32_32x32x16_bf16(PAF(3), VFR(7), o[3], 0, 0, 0); SBAR(); } \
    } while (0)
  int t = 1;
  for (; t + 5 < NT; t += 2) {
    STEP(pB0, pB1, pA0, pA1, t, true, true, true);     if constexpr (DV2 == 2) { WAIT_BAR(3); } else { WAIT_BAR(2); } RESC(); ROT();
    STEP(pA0, pA1, pB0, pB1, t + 1, true, true, true); if constexpr (DV2 == 2) { WAIT_BAR(3); } else { WAIT_BAR(2); } RESC(); ROT();
  }
  #define ENDW(tt) do { if constexpr (DV2 == 2) { if ((tt) + 3 < NT) { WAIT_BAR(3); } else if ((tt) + 2 < NT) { WAIT_BAR(2); } else { WAIT_BAR(0); } } \
    else { if ((tt) + 3 < NT) { WAIT_BAR(2); } else if ((tt) + 2 < NT) { WAIT_BAR(1); } else { WAIT_BAR(0); } } } while (0)
  for (; t + 1 < NT; t += 2) {
    STEP(pB0, pB1, pA0, pA1, t, (t + 3 < NT), (t + 1 < NT), (t + 1 < NT));         ENDW(t);     RESC(); ROT();
    STEP(pA0, pA1, pB0, pB1, t + 1, (t + 4 < NT), (t + 2 < NT), (t + 2 < NT));     ENDW(t + 1); RESC(); ROT();
  }
  STEP(pB0, pB1, pA0, pA1, NT - 1, false, false, false); RESC();
  { float sacc = pB0[0] + pB0[1]; _Pragma("unroll") for (int r = 2; r < 16; ++r) sacc += pB0[r]; _Pragma("unroll") for (int r = 0; r < 16; ++r) sacc += pB1[r]; l_reg += sacc;
    pw0 = (u32x4){PKW(pB0, 0), PKW(pB0, 2), PKW(pB0, 4), PKW(pB0, 6)}; pw1 = (u32x4){PKW(pB0, 8), PKW(pB0, 10), PKW(pB0, 12), PKW(pB0, 14)}; pw2 = (u32x4){PKW(pB1, 0), PKW(pB1, 2), PKW(pB1, 4), PKW(pB1, 6)}; pw3 = (u32x4){PKW(pB1, 8), PKW(pB1, 10), PKW(pB1, 12), PKW(pB1, 14)};
    SBAR(); pv(o, vb0 + DV2 * sl_cur, PAF(0), PAF(1), PAF(2), PAF(3)); if constexpr (DV2 == 2) pv(o + 2, vb0 + DV2 * sl_cur + 8192, PAF(0), PAF(1), PAF(2), PAF(3)); }
  #undef PKW
  #undef PAF
  #undef VFR
  #undef PIN
  #undef MX3
  #undef GAPA
  #undef GAPB
  #undef EX
  #undef VRD
  #undef KRD
  #undef VRD2
  #undef STEP
  #undef ENDW
  { auto rr = __builtin_amdgcn_permlane32_swap(__float_as_uint(l_reg), __float_as_uint(l_reg), false, false); l_reg = __uint_as_float(rr[0]) + __uint_as_float(rr[1]); }
  int lane_e; asm volatile("v_mbcnt_lo_u32_b32 %0, -1, 0\n\tv_mbcnt_hi_u32_b32 %0, -1, %0" : "=v"(lane_e));
  const int r32e = lane_e & 31, hie = lane_e >> 5;
  if (hie == 0) wsf[32 + r32e] = l_reg; asm volatile("s_waitcnt lgkmcnt(0)" ::: "memory");
  float rli[16];
  #pragma unroll
  for (int r = 0; r < 16; ++r) rli[r] = __builtin_amdgcn_rcpf(wsf[32 + crow(r, hie)]);
  bf16* Ow = Oh + (long)(q0 + wid * QBLK) * OP;
  { bf16* stg = (bf16*)(shm + LDS_OST) + wid * 2048;
    if (DV2 == 2 && comb) {
      asm volatile("s_waitcnt vmcnt(0)" ::: "memory");
      u32x4 w1a[2][4];
      #pragma unroll
      for (int hv = 0; hv < DV2; ++hv)
        #pragma unroll
        for (int i = 0; i < 4; ++i) { const int row = i * 8 + (lane_e >> 3), ch = lane_e & 7; w1a[hv][i] = *(const u32x4*)(Ow + (long)row * OP + hv * 64 + ch * 8); }
      float dd[2][4][8]; float ss[4] = {0.f, 0.f, 0.f, 0.f};
      #pragma unroll
      for (int hv = 0; hv < DV2; ++hv) {
        #pragma unroll
        for (int r = 0; r < 16; ++r) { const int orow = crow(r, hie);
          #pragma unroll
          for (int d0 = 0; d0 < 2; ++d0) stg[orow * 64 + d0 * 32 + r32e] = __float2bfloat16(o[2 * hv + d0][r] * rli[r]); }
        asm volatile("s_waitcnt lgkmcnt(0)" ::: "memory");
        #pragma unroll
        for (int i = 0; i < 4; ++i) { const int row = i * 8 + (lane_e >> 3), ch = lane_e & 7; const u32x4 v = *(const u32x4*)(stg + row * 64 + ch * 8);
          const u32x4 w1 = w1a[hv][i];
          #pragma unroll
          for (int j = 0; j < 4; ++j) { const float a0 = __uint_as_float(w1[j] << 16), a1 = __uint_as_float(w1[j] & 0xffff0000u), b0 = __uint_as_float(v[j] << 16), b1 = __uint_as_float(v[j] & 0xffff0000u);
            const float e0 = a0 - lam * b0, e1 = a1 - lam * b1; dd[hv][i][2 * j] = e0; dd[hv][i][2 * j + 1] = e1; ss[i] += e0 * e0 + e1 * e1; } }
        asm volatile("s_waitcnt lgkmcnt(0)" ::: "memory"); }
      #pragma unroll
      for (int i = 0; i < 4; ++i) {
        float t = ss[i];
        #pragma unroll
        for (int m_ = 1; m_ < 8; m_ <<= 1) t += __builtin_bit_cast(float, __builtin_amdgcn_ds_bpermute((lane_e ^ m_) << 2, __builtin_bit_cast(int, t)));
        const float rinv = (1.0f - 0.47071301834358366f) / sqrtf(t * (1.0f / 128.0f) + 1e-6f);
        const int row = i * 8 + (lane_e >> 3), ch = lane_e & 7;
        #pragma unroll
        for (int hv = 0; hv < DV2; ++hv) { const float* gp = subln + hv * 64 + ch * 8; u32x4 w;
          #pragma unroll
          for (int j = 0; j < 4; ++j) w[j] = cvtpk_s(dd[hv][i][2 * j] * rinv * gp[2 * j], dd[hv][i][2 * j + 1] * rinv * gp[2 * j + 1]);
          *(u32x4*)(Ow + (long)row * OP + hv * 64 + ch * 8) = w; } }
    } else {
    #pragma unroll
    for (int hv = 0; hv < DV2; ++hv) {
    #pragma unroll
    for (int r = 0; r < 16; ++r) { const int orow = crow(r, hie);
      #pragma unroll
      for (int d0 = 0; d0 < 2; ++d0) stg[orow * 64 + d0 * 32 + r32e] = __float2bfloat16(o[2 * hv + d0][r] * rli[r]); }
    asm volatile("s_waitcnt lgkmcnt(0)" ::: "memory");
    #pragma unroll
    for (int i = 0; i < 4; ++i) { const int row = i * 8 + (lane_e >> 3), ch = lane_e & 7; const u32x4 v = *(const u32x4*)(stg + row * 64 + ch * 8); *(u32x4*)(Ow + (long)row * OP + hv * 64 + ch * 8) = v; }
    asm volatile("s_waitcnt lgkmcnt(0)" ::: "memory"); } } }
  asm volatile("s_waitcnt lgkmcnt(0)\n\ts_barrier" ::: "memory");
  #undef DMA_K
  #undef DMA_V
  #undef START
  #undef RESC
  #undef ROT
}
#undef SBAR
#undef WAIT_BAR
}

#define LDS_WAIT() asm volatile("s_waitcnt lgkmcnt(0)" ::: "memory")
__device__ __forceinline__ unsigned f2bf(float f) { unsigned u = __builtin_bit_cast(unsigned, f); return (u + 0x7fffu + ((u >> 16) & 1u)) >> 16; }
__device__ __forceinline__ unsigned pk2(float lo, float hi) { return f2bf(lo) | (f2bf(hi) << 16); }
__device__ __forceinline__ f32x4 cvh4(unsigned a, unsigned b) { return (f32x4){(float)__builtin_bit_cast(_Float16, (unsigned short)(a & 0xffffu)), (float)__builtin_bit_cast(_Float16, (unsigned short)(a >> 16)), (float)__builtin_bit_cast(_Float16, (unsigned short)(b & 0xffffu)), (float)__builtin_bit_cast(_Float16, (unsigned short)(b >> 16))}; }
__device__ __forceinline__ f32x4 ldh4(const bf16_t* p) { const u32x2 w = *(const u32x2*)p; return (f32x4){(float)__builtin_bit_cast(_Float16, (unsigned short)(w.x & 0xffffu)), (float)__builtin_bit_cast(_Float16, (unsigned short)(w.x >> 16)), (float)__builtin_bit_cast(_Float16, (unsigned short)(w.y & 0xffffu)), (float)__builtin_bit_cast(_Float16, (unsigned short)(w.y >> 16))}; }
__device__ __forceinline__ float bf2f(unsigned short b) { return __builtin_bit_cast(float, (unsigned)b << 16); }
__device__ __forceinline__ float wave_sum(float v, int lane) {
#pragma unroll
    for (int o = 1; o < 64; o <<= 1) v += shx(v, lane, o);
    return v;
}
__device__ __forceinline__ int wpos(int mode, int L) {
    if (mode == 1) { const int d = L & 63, fq = 2 * (d >> 5) + ((d >> 3) & 1); return (L & ~255) + ((d >> 4) & 1) * 128 + ((L >> 6) & 3) * 32 + 8 * fq + (d & 7); }
    if (mode == 2) { const int bj = L >= DFF ? 1 : 0, rem = L - bj * DFF; return (rem >> 7) * 256 + bj * 128 + (rem & 127); }
    return L;
}
__device__ __forceinline__ void transpose_item(const float* W, int K, int N, bf16_t* WT, int mode, LAS float* scr, int item, int lane) {
    const int nblk = N / 32, kb = item / nblk, nb = item % nblk, k0 = 64 * kb, n0 = 32 * nb;
    {
        const int rr = lane >> 3, c4 = (lane & 7) * 4;
        f32x4 v[8];
#pragma unroll
        for (int i = 0; i < 8; ++i) v[i] = *(const f32x4*)(W + (size_t)(k0 + 8 * i + rr) * N + n0 + c4);
#pragma unroll
        for (int i = 0; i < 8; ++i) { LAS float* d = scr + (8 * i + rr) * 33 + c4; d[0] = v[i].x; d[1] = v[i].y; d[2] = v[i].z; d[3] = v[i].w; }
    }
    LDS_WAIT(); asm volatile("" ::: "memory");
    const int c = lane & 7;
#pragma unroll
    for (int j = 0; j < 4; ++j) { const int n = (lane >> 3) + 8 * j; const LAS float* s = scr + (8 * c) * 33 + n;
        u32x4 o; o.x = pk2(s[0 * 33], s[1 * 33]); o.y = pk2(s[2 * 33], s[3 * 33]); o.z = pk2(s[4 * 33], s[5 * 33]); o.w = pk2(s[6 * 33], s[7 * 33]);
        *(u32x4*)(WT + (size_t)wpos(mode, n0 + n) * K + k0 + 8 * c) = o; }
    LDS_WAIT(); asm volatile("" ::: "memory");
}


#define XB_TMO      128
#define XB_XCNT(j)  (256  + 64 * (j))
#define XB_XSUB(j)  (1280 + 64 * (j))
#define XB_XGEN(j)  (2304 + 64 * (j))
#define XB_TOP      3328
#define XB_TOPGEN   3392
#define XCD_BAR_WORDS 3456
#define XB_SPIN_CAP (1u << 22)
__device__ __forceinline__ unsigned xb_ld(unsigned* p)              { return __hip_atomic_load(p, __ATOMIC_RELAXED, __HIP_MEMORY_SCOPE_AGENT); }
__device__ __forceinline__ unsigned xb_add(unsigned* p, unsigned v) { return __hip_atomic_fetch_add(p, v, __ATOMIC_RELAXED, __HIP_MEMORY_SCOPE_AGENT); }
__device__ __forceinline__ unsigned xb_xcc_id() { return (unsigned)__builtin_amdgcn_s_getreg((3 << 11) | 20) & 0xFu; }
#define XB_SPIN(cond, bar) do { unsigned _sp = 0; while (cond) { __builtin_amdgcn_s_sleep(1); \
    if ((++_sp & 255u) == 0u) { if (xb_ld(&(bar)[XB_TMO])) break; if (_sp > XB_SPIN_CAP) { atomicAdd(&(bar)[XB_TMO], 1u); break; } } } } while (0)
struct XcdBarrier { unsigned* bar; unsigned x; volatile LAS unsigned* st; };
__device__ __forceinline__ void xcd_barrier_complete(unsigned* bar, unsigned x, unsigned& nloc, unsigned& nx) {
    const unsigned G = gridDim.x * gridDim.y * gridDim.z;
    unsigned sum, cnt, mine, sp = 0u;
    for (;;) {
        sum = 0u; cnt = 0u; mine = 0u;
#pragma unroll
        for (unsigned j = 0; j < 16; ++j) { const unsigned c = xb_ld(&bar[XB_XCNT(j)]); sum += c; cnt += (c > 0u) ? 1u : 0u; mine = (j == x) ? c : mine; }
        if (sum == G) break;
        __builtin_amdgcn_s_sleep(1);
        if ((++sp & 255u) == 0u) { if (xb_ld(&bar[XB_TMO])) break; if (sp > XB_SPIN_CAP) { atomicAdd(&bar[XB_TMO], 1u); break; } }
    }
    nloc = mine > 0u ? mine : 1u; nx = cnt > 0u ? cnt : 1u;
}
__device__ __forceinline__ void xcd_barrier(const XcdBarrier& b) {
    asm volatile("s_waitcnt vmcnt(0)" ::: "memory");
    __syncthreads();
    if (threadIdx.x == 0) {
        unsigned* bar = b.bar;
        __builtin_amdgcn_s_waitcnt(0);
        unsigned nloc = b.st[0], nx = b.st[1];
        if (nloc == 0u) { xcd_barrier_complete(bar, b.x, nloc, nx); b.st[0] = nloc; b.st[1] = nx; }
        const unsigned old = xb_add(&bar[XB_XSUB(b.x)], 1u);
        const unsigned gen = old / nloc;
        if (old + 1u == (gen + 1u) * nloc) {
            __builtin_amdgcn_fence(__ATOMIC_RELEASE, "agent");
            asm volatile("s_waitcnt vmcnt(0)" ::: "memory");
            const unsigned og = xb_add(&bar[XB_TOP], 1u);
            const unsigned tg = og / nx;
            if (og + 1u == (tg + 1u) * nx) xb_add(&bar[XB_TOPGEN], 1u);
            else XB_SPIN(xb_ld(&bar[XB_TOPGEN]) == tg, bar);
            __builtin_amdgcn_fence(__ATOMIC_ACQUIRE, "agent");
            xb_add(&bar[XB_XGEN(b.x)], 1u);
            asm volatile("s_waitcnt vmcnt(0)" ::: "memory");
        } else {
            XB_SPIN(xb_ld(&bar[XB_XGEN(b.x)]) == gen, bar);
            __builtin_amdgcn_fence(__ATOMIC_ACQUIRE, "agent");
            asm volatile("s_waitcnt vmcnt(0)" ::: "memory");
        }
    }
    __syncthreads();
}

struct Args { const float* in[50]; float* out; unsigned char* ws; };

__global__ void __launch_bounds__(512, 2) mk_fwd(Args a) {
    extern __shared__ __attribute__((aligned(16))) unsigned char lds[];
    cg::grid_group grid = cg::this_grid();
    LAS unsigned char* ldsl = (LAS unsigned char*)lds;
    const int G = gridDim.x, bid = blockIdx.x;
    const int wave0 = __builtin_amdgcn_readfirstlane((int)threadIdx.x >> 6);
    if (bid == 0) { for (int i = threadIdx.x; i < XCD_BAR_WORDS; i += 512) __hip_atomic_store((unsigned*)a.ws + i, 0u, __ATOMIC_RELAXED, __HIP_MEMORY_SCOPE_AGENT); }
    for (int i = bid * 512 + threadIdx.x; i < 8 * 128 * 64; i += G * 512) __hip_atomic_store((unsigned*)a.ws + 16384 + i, 0u, __ATOMIC_RELAXED, __HIP_MEMORY_SCOPE_AGENT);
    if (threadIdx.x < 64) ((volatile LAS unsigned*)(ldsl + 131072 + 512))[threadIdx.x] = 0u;
    __syncthreads();
    const int vcu = (G % 8 == 0) ? (bid % 8) * (G / 8) + bid / 8 : bid;
    const int NGW = G * 8;
#define PHASE_VARS int lane; asm volatile("v_mbcnt_lo_u32_b32 %0, -1, 0\n\tv_mbcnt_hi_u32_b32 %0, -1, %0" : "=v"(lane)); const int wave = wave0, tid = wave0 * 64 + lane, gw = vcu * 8 + wave; unsigned char* ws = a.ws; asm volatile("" : "+s"(ws)); (void)lane; (void)gw;
    { PHASE_VARS
    bf16_t* XB = (bf16_t*)(ws + WS_XB);
    float* axc = (float*)(ws + WS_AXC); float* axs = (float*)(ws + WS_AXS); float* rcT = (float*)(ws + WS_RC); float* rsT = (float*)(ws + WS_RS);

    {
        LAS float* scr = (LAS float*)(ldsl + wave * 16384);
        constexpr int I_UP = (DM / 64) * (NUP / 32), I_DN = (DFF / 64) * (DM / 32), I_Q0 = (DM / 64) * (1536 / 32), I_SQ = (DM / 64) * (DM / 32), I_Q2 = (DM / 64) * (3072 / 32);
        constexpr int NITEMS = 4 * I_UP + 4 * I_DN + 2 * I_Q0 + 4 * I_SQ + I_Q2;
#define TR(SRC, KK, NN, DSTOFF, MODE, NI) { if (r < (NI)) { transpose_item(a.in[SRC], KK, NN, (bf16_t*)(ws + (DSTOFF)), MODE, scr, r, lane); continue; } r -= (NI); }
        for (int it = gw; it < NITEMS; it += NGW) {
            int r = it;
            TR(7, DM, NUP, WS_WUP, 2, I_UP) TR(17, DM, NUP, WS_WUP + 11 * MiB, 2, I_UP) TR(32, DM, NUP, WS_WUP + 22 * MiB, 2, I_UP) TR(44, DM, NUP, WS_WUP + 33 * MiB, 2, I_UP)
            TR(10, DFF, DM, WS_WDN, 0, I_DN) TR(20, DFF, DM, WS_WDN + 5767168, 0, I_DN) TR(35, DFF, DM, WS_WDN + 2 * 5767168, 0, I_DN) TR(47, DFF, DM, WS_WDN + 3 * 5767168, 0, I_DN)
            TR(1, DM, 1536, WS_QKV0, 1, I_Q0) TR(38, DM, 1536, WS_QKV3, 1, I_Q0)
            TR(4, DM, DM, WS_WO0, 0, I_SQ) TR(13, DM, DM, WS_FWO, 0, I_SQ) TR(29, DM, DM, WS_WO2, 0, I_SQ) TR(41, DM, DM, WS_WO3, 0, I_SQ)
            TR(23, DM, 3072, WS_QKV2, 0, I_Q2)
        }
#undef TR
        for (int m = gw; m < MROWS; m += NGW) {
            const f32x4* xr = (const f32x4*)(a.in[0] + (size_t)m * DM) + lane; unsigned long long* o8 = (unsigned long long*)(XB + (size_t)m * DM) + lane; unsigned long long* h8 = (unsigned long long*)((bf16_t*)a.out + (size_t)MROWS * DM + (size_t)m * DM) + lane;
#pragma unroll
            for (int j = 0; j < 4; ++j) { const f32x4 v = xr[64 * j]; o8[64 * j] = (unsigned long long)pk2(v.x, v.y) | ((unsigned long long)pk2(v.z, v.w) << 32);
                (void)h8; }
        }
        const int gt = vcu * 512 + tid, GT = G * 512;
        for (int i = gt; i < 512 * 256; i += GT) { const int n = i >> 8, c = i & 255, part = n >> 8, m = n & 255; const float ph = (float)((m * c) & 255) * (1.0f / 256.0f);
            const float v = part ? -__builtin_amdgcn_sinf(ph) : __builtin_amdgcn_cosf(ph); ((bf16_t*)(ws + WS_TT))[i] = (bf16_t)f2bf(v); }
        { bf16_t* A2 = (bf16_t*)(ws + WS_A2);
          for (int i = gt; i < 2048 * 4096 / 2; i += GT) { const int e = i * 2, k = e >> 12, c = e & 4095, part = c >> 11, s = c & 2047;
              const float p0 = (float)((k * s) & 4095) * (1.0f / 4096.0f), p1 = (float)((k * (s + 1)) & 4095) * (1.0f / 4096.0f);
              const float v0 = part ? __builtin_amdgcn_sinf(p0) : __builtin_amdgcn_cosf(p0), v1 = part ? __builtin_amdgcn_sinf(p1) : __builtin_amdgcn_cosf(p1);
              ((unsigned*)A2)[i] = pk2(v0, v1); } }
        for (int i = gt; i < 64 * 16; i += GT) { const int t = i >> 4, f = i & 15; const float inv = powf(10000.0f, -(float)(2 * f) / 32.0f); const float ang = (float)t * inv; axc[i] = cosf(ang); axs[i] = sinf(ang); }
        for (int i = gt; i < 4096 * 8; i += GT) { const int t = i >> 3, f = i & 7; const float inv = powf(500000.0f, -(float)(2 * f) / 16.0f); const float ang = (float)t * inv; rcT[i] = cosf(ang); rsT[i] = sinf(ang); }
    }
    }
    grid.sync();
    XcdBarrier xbar; xbar.bar = (unsigned*)a.ws; xbar.x = xb_xcc_id(); xbar.st = (volatile LAS unsigned*)(ldsl + 131072 + 512);
    if (threadIdx.x == 0) (void)xb_add(&xbar.bar[XB_XCNT(xbar.x)], 1u);
#define GSYNC() xcd_barrier(xbar)
    float* OUT = a.out;

    for (int l = 0; l < 4; ++l) {
        const int kind = (l == 3) ? 0 : l;
        for (int h = 0; h < 2; ++h) {
            const char* rA; size_t rBoff; int rK; const float* rbias = nullptr; const float* lng; const float* lnb;
            if (h == 0) {
                if (kind == 0) {
                    { PHASE_VARS
                      pg8::StaticOrder S; S.init(MROWS / 256, 1536 / 256, G, bid);
                      pg8::MapStd MP{(const char*)(ws + WS_XB), (const char*)(ws + (l == 0 ? WS_QKV0 : WS_QKV3)), (size_t)DM * 2, (size_t)DM * 2};
                      pg8::EpiQkvGqa E{(GAS bf16_t*)(ws + WS_QKV), (const GAS float*)(l == 0 ? a.in[2] : a.in[39]), (const GAS float*)(l == 0 ? a.in[3] : a.in[40]), (const GAS float*)(ws + WS_AXC), (const GAS float*)(ws + WS_AXS)};
                      pg8::gemm_phase<pg8::EpiQkvGqa, pg8::MapStd, true>(tid, ldsl, DM, DM, DM, MP, S, E); }
                    GSYNC();
                    { PHASE_VARS
                      const attn_body::bf16* QKV = (const attn_body::bf16*)(ws + WS_QKV); attn_body::bf16* O = (attn_body::bf16*)(ws + WS_O_GQA);
                      float gq = fabsf((l == 0 ? a.in[2] : a.in[39])[lane]), gk = fabsf((l == 0 ? a.in[3] : a.in[40])[lane]);
#pragma unroll
                      for (int o = 1; o < 64; o <<= 1) { gq = fmaxf(gq, shx(gq, lane, o)); gk = fmaxf(gk, shx(gk, lane, o)); }
                      const bool bounded = __builtin_amdgcn_readfirstlane((int)(11.8f * gq * gk < 90.0f)) != 0;
                      if (bounded) {
                        for (int U = vcu; U < 2048; U += G) {
                          const int grp = U >> 6, rest = U & 63, g = rest >> 4, qb = rest & 15, b = grp >> 2, kvh = grp & 3, hq = kvh * 4 + g;
                          const attn_body::bf16* base = QKV + (size_t)b * SEQ * 1536;
                          attn_body::attn_unit<8, 1536, 1, true>(qb * 256, base + hq * 64, base + 1024 + kvh * 64, base + 1280 + kvh * 64, O + (size_t)b * SEQ * DM + hq * 64, (char*)lds, tid);
                        }
                      } else {
                        for (int U = vcu; U < 2048; U += G) {
                          const int grp = U >> 6, rest = U & 63, g = rest >> 4, qb = rest & 15, b = grp >> 2, kvh = grp & 3, hq = kvh * 4 + g;
                          const attn_body::bf16* base = QKV + (size_t)b * SEQ * 1536;
                          attn_body::attn_unit<8, 1536, 1, false>(qb * 256, base + hq * 64, base + 1024 + kvh * 64, base + 1280 + kvh * 64, O + (size_t)b * SEQ * DM + hq * 64, (char*)lds, tid);
                        }
                      } }
                    GSYNC();
                    rA = (const char*)(a.ws + WS_O_GQA); rBoff = (l == 0 ? WS_WO0 : WS_WO3); rK = DM;
                } else if (kind == 1) {
                    { PHASE_VARS
                      const bf16_t* XB = (const bf16_t*)(ws + WS_XB); bf16_t* XE = (bf16_t*)(ws + WS_XE); bf16_t* XO = XE + (size_t)NB * 2048 * DM;
                      for (int r = gw; r < NB * 2048; r += NGW) {
                          const int b = r >> 11, sidx = r & 2047;
                          const u32x2* p = (const u32x2*)(XB + ((size_t)b * SEQ + sidx) * DM) + lane; const u32x2* q = (const u32x2*)(XB + ((size_t)b * SEQ + ((SEQ - sidx) & (SEQ - 1))) * DM) + lane;
                          u32x2* pe = (u32x2*)(XE + (size_t)r * DM) + lane; u32x2* po = (u32x2*)(XO + (size_t)r * DM) + lane;
#pragma unroll
                          for (int j = 0; j < 4; ++j) { const u32x2 x1 = p[64 * j], x2 = q[64 * j];
                              const float a0 = bf2f(x1.x & 0xffff), a1 = bf2f(x1.x >> 16), a2 = bf2f(x1.y & 0xffff), a3 = bf2f(x1.y >> 16);
                              const float b0 = bf2f(x2.x & 0xffff), b1 = bf2f(x2.x >> 16), b2 = bf2f(x2.y & 0xffff), b3 = bf2f(x2.y >> 16);
                              u32x2 e, o;
                              if (sidx == 0) { e = x1; o.x = 0u; o.y = 0u; }
                              else { e.x = pk2(a0 + b0, a1 + b1); e.y = pk2(a2 + b2, a3 + b3); o.x = pk2(a0 - b0, a1 - b1); o.y = pk2(a2 - b2, a3 - b3); }
                              pe[64 * j] = e; po[64 * j] = o; }
                      }
                      const int gt = vcu * 512 + tid;
                      if (gt < NB * DM) { const int b = gt >> 10, ch = gt & 1023, g = ch >> 8, m = ch & 255; const bf16_t* xr = XB + ((size_t)b * SEQ + 2048) * DM + g * 256; float acc_ = 0.f;
                          for (int c = 0; c < 256; ++c) acc_ += bf2f(xr[c]) * __builtin_amdgcn_cosf((float)((m * c) & 255) * (1.0f / 256.0f));
                          ((float*)(ws + WS_YCH))[gt] = acc_; }
                    }
                    GSYNC();
                    { PHASE_VARS
                      pg8::StaticOrder S; S.init(8, 64, G, bid);
                      pg8::MapF1 MP{(const char*)(ws + WS_TT), (const char*)(ws + WS_XE)};
                      pg8::EpiBf16<1> E{(GAS bf16_t*)(ws + WS_YT), 1.0f, (const GAS float*)nullptr};
                      pg8::gemm_phase<pg8::EpiBf16<1>, pg8::MapF1, true>(tid, ldsl, 256, DM, 256, MP, S, E); }
                    GSYNC();
                    { PHASE_VARS
                      { const bf16_t* YT = (const bf16_t*)(ws + WS_YT); const float* ych = (const float*)(ws + WS_YCH); bf16_t* Zb = (bf16_t*)OUT;
                        for (int r = gw; r < NB * DM; r += NGW) { const u32x4* p = (const u32x4*)(YT + (size_t)r * 4096) + lane; float sacc = 0.f;
#pragma unroll
                            for (int j = 0; j < 4; ++j) { const u32x4 w = p[64 * j];
#pragma unroll
                                for (int t = 0; t < 4; ++t) sacc += bf2f((unsigned short)(w[t] & 0xffffu)) - bf2f((unsigned short)(w[t] >> 16)); }
                            sacc = wave_sum(sacc, lane);
                            if (lane == 0) Zb[((size_t)(r >> 10) * SEQ + 2048) * DM + (r & 1023)] = (bf16_t)f2bf((sacc + ych[r]) * (1.0f / 1024.0f)); } }
                      pg8::StaticOrder S; S.init(128, 4, G, bid);
                      pg8::MapF2 MP{(const char*)(ws + WS_A2), (const char*)(ws + WS_YT)};
                      pg8::EpiF2s E{(GAS bf16_t*)OUT, 1.0f / 1024.0f, (const GAS float*)(ws + WS_YCH), (GAS float*)(ws + WS_R + 128 * MiB)};
                      pg8::gemm_phase<pg8::EpiF2s, pg8::MapF2, true>(tid, ldsl, 4096, 4096, 2048, MP, S, E); }
                    GSYNC();
                    rA = (const char*)OUT; rBoff = WS_FWO; rK = DM; rbias = a.in[14];
                } else {
                    { PHASE_VARS
                      pg8::StaticOrder S; S.init(MROWS / 256, 3072 / 256, G, bid);
                      pg8::MapStd MP{(const char*)(ws + WS_XB), (const char*)(ws + WS_QKV2), (size_t)DM * 2, (size_t)DM * 2};
                      pg8::EpiQkvDiff E{(GAS bf16_t*)(ws + WS_QKV), (const GAS float*)(ws + WS_RC), (const GAS float*)(ws + WS_RS)};
                      pg8::gemm_phase<pg8::EpiQkvDiff, pg8::MapStd, true>(tid, ldsl, DM, DM, DM, MP, S, E); }
                    GSYNC();
                    { PHASE_VARS
                      const attn_body::bf16* QKV = (const attn_body::bf16*)(ws + WS_QKV); attn_body::bf16* O1 = (attn_body::bf16*)(ws + WS_O12);
                      float d1 = a.in[24][lane] * a.in[25][lane], d2 = a.in[26][lane] * a.in[27][lane];
                      d1 = wave_sum(d1, lane); d2 = wave_sum(d2, lane);
                      const float lam = expf(d1) - expf(d2) + LAMBDA_INIT2;
                      for (int i = 0; i < 8; ++i) {
                          const int V = (i >> 1) * G + vcu; if (V >= 1024) break;
                          const int c = i & 1, grp = V >> 4, qb = V & 15, b = grp >> 3, hh = grp & 7;
                          const attn_body::bf16* base = QKV + (size_t)b * SEQ * 3072;
                          attn_body::attn_unit<8, 3072, 2>(qb * 256, base + (2 * hh + c) * 64, base + 1024 + (2 * hh + c) * 64, base + 2048 + hh * 128,
                                                  O1 + (size_t)b * SEQ * DM + hh * 128, (char*)lds, tid, c == 1, lam, a.in[28]);
                      } }
                    GSYNC();
                    rA = (const char*)(a.ws + WS_O12); rBoff = WS_WO2; rK = DM;
                }
                lng = a.in[l == 0 ? 5 : l == 1 ? 15 : l == 2 ? 30 : 42]; lnb = a.in[l == 0 ? 6 : l == 1 ? 16 : l == 2 ? 31 : 43];
            } else {
                const float* cw = a.in[l == 0 ? 8 : l == 1 ? 18 : l == 2 ? 33 : 45]; const float* cb = a.in[l == 0 ? 9 : l == 1 ? 19 : l == 2 ? 34 : 46];
                { PHASE_VARS
                  pg8::StaticOrder S; S.init(MROWS / 256, NUP / 256, G, bid);
                  pg8::MapStd MP{(const char*)(ws + WS_XB), (const char*)(ws + WS_WUP + (size_t)l * 11 * MiB), (size_t)DM * 2, (size_t)DM * 2};
                  pg8::EpiUpConv E{(GAS bf16_t*)(ws + WS_G), (GAS bf16_t*)(ws + WS_E), (const GAS float*)cw, (const GAS float*)cb};
                  pg8::gemm_phase<pg8::EpiUpConv, pg8::MapStd, true>(tid, ldsl, DM, DM, DM, MP, S, E); }
                GSYNC();
                { PHASE_VARS
                  bf16_t* Gb = (bf16_t*)(ws + WS_G); const bf16_t* Eb = (const bf16_t*)(ws + WS_E);
                  for (int it = gw; it < (MROWS / 32) * 6; it += NGW) {
                    const int ri = it / 6, ch = it - ri * 6;
                    const int blk = ri >> 1, side = ri & 1, row = blk * 64 + (side ? 63 : 0), s = row & (SEQ - 1);
                    const bf16_t* eu; const bf16_t* em; const bf16_t* ed; bool hasu = true, hasd = true;
                    if (side == 0) { hasu = (s != 0); eu = Eb + ((size_t)(blk - (hasu ? 1 : 0)) * 4 + 3) * NUP; em = Eb + ((size_t)blk * 4 + 0) * NUP; ed = Eb + ((size_t)blk * 4 + 1) * NUP; }
                    else { hasd = (s != SEQ - 1); eu = Eb + ((size_t)blk * 4 + 2) * NUP; em = Eb + ((size_t)blk * 4 + 3) * NUP; ed = Eb + ((size_t)(blk + (hasd ? 1 : 0)) * 4 + 0) * NUP; }
                    const float fu = hasu ? 1.f : 0.f, fd = hasd ? 1.f : 0.f;
                    const int c = ch * 512 + 8 * lane;
                    if (c < DFF) {
                        f32x4 hgv[2][2];
#pragma unroll
                        for (int p = 0; p < 2; ++p) { const u32x4 wu = *(const u32x4*)(eu + c + p * DFF), wm = *(const u32x4*)(em + c + p * DFF), wd = *(const u32x4*)(ed + c + p * DFF);
#pragma unroll
                            for (int q4 = 0; q4 < 2; ++q4) { const int cc = c + p * DFF + 4 * q4;
                                const f32x4 u4 = cvh4(wu[2 * q4], wu[2 * q4 + 1]) * fu, m4 = cvh4(wm[2 * q4], wm[2 * q4 + 1]), d4 = cvh4(wd[2 * q4], wd[2 * q4 + 1]) * fd;
                                hgv[p][q4] = *(const f32x4*)(cb + cc) + *(const f32x4*)(cw + cc) * u4 + *(const f32x4*)(cw + NUP + cc) * m4 + *(const f32x4*)(cw + 2 * NUP + cc) * d4; } }
                        u32x4 w;
                        w.x = pk2(pg8::silu_mul(hgv[0][0][0], hgv[1][0][0]), pg8::silu_mul(hgv[0][0][1], hgv[1][0][1])); w.y = pk2(pg8::silu_mul(hgv[0][0][2], hgv[1][0][2]), pg8::silu_mul(hgv[0][0][3], hgv[1][0][3]));
                        w.z = pk2(pg8::silu_mul(hgv[0][1][0], hgv[1][1][0]), pg8::silu_mul(hgv[0][1][1], hgv[1][1][1])); w.w = pk2(pg8::silu_mul(hgv[0][1][2], hgv[1][1][2]), pg8::silu_mul(hgv[0][1][3], hgv[1][1][3]));
                        *(u32x4*)(Gb + (size_t)row * DFF + c) = w;
                    }
                  } }
                GSYNC();
                rA = (const char*)(a.ws + WS_G); rBoff = WS_WDN + (size_t)l * 5767168; rK = DFF;
                lng = a.in[l == 0 ? 11 : l == 1 ? 21 : l == 2 ? 36 : 48]; lnb = a.in[l == 0 ? 12 : l == 1 ? 22 : l == 2 ? 37 : 49];
            }
            { PHASE_VARS
              pg8::StaticOrder S; S.init(MROWS / 256, DM / 256, G, bid);
              pg8::MapStd MP{rA, (const char*)(ws + rBoff), (size_t)rK * 2, (size_t)rK * 2};
              pg8::PanelStats st{(unsigned*)(ws + 89 * MiB), (unsigned*)ws + 16384 + (l * 2 + h) * 128 * 64, ldsl + 131072 + 1024};
              const int q = 2 * l + h; bf16_t* XHo = (bf16_t*)OUT + (size_t)MROWS * DM;
              constexpr int QB16 = 3;
              pg8::EpiResidLn E{(GAS float*)(q == 7 ? OUT : nullptr), (GAS bf16_t*)(q == 7 ? nullptr : (bf16_t*)(ws + WS_XB)),
                                 (const GAS bf16_t*)(q <= QB16 ? (bf16_t*)(ws + WS_XB) : q == 7 ? (bf16_t*)(ws + WS_XH7) : XHo), (GAS bf16_t*)((q == 7 || q < QB16) ? nullptr : q == 6 ? (bf16_t*)(ws + WS_XH7) : XHo), (const GAS float*)rbias, (const GAS float*)lng, (const GAS float*)lnb, st, q <= QB16};
              pg8::gemm_phase<pg8::EpiResidLn, pg8::MapStd, true>(tid, ldsl, rK, rK, rK, MP, S, E); }
            GSYNC();
        }
    }
}

extern "C" void kernel_launch(void* const* d_in, const int* in_sizes, int n_in, void* d_out, int out_size, void* d_ws, size_t ws_size, hipStream_t stream) {
    static int grid = 0;
    if (grid == 0) {
        if (n_in != 50 || out_size != MROWS * DM || ws_size < WS_NEED) { fprintf(stderr, "kernel_launch: unexpected shapes n_in %d out %d ws %zu\n", n_in, out_size, ws_size); grid = -1; return; }
        int dev = 0, cus = 0, per_cu = 0;
        (void)hipGetDevice(&dev); (void)hipDeviceGetAttribute(&cus, hipDeviceAttributeMultiprocessorCount, dev);
        (void)hipFuncSetAttribute((const void*)mk_fwd, hipFuncAttributeMaxDynamicSharedMemorySize, LDS_BYTES);
        (void)hipOccupancyMaxActiveBlocksPerMultiprocessor(&per_cu, (const void*)mk_fwd, 512, LDS_BYTES);
        if (per_cu < 1) per_cu = 1;
        grid = cus * per_cu;
        fprintf(stderr, "kernel_launch: grid %d (cus %d x %d)\n", grid, cus, per_cu);
    }
    if (grid < 0) return;
    Args a{};
    for (int i = 0; i < 50; ++i) a.in[i] = (const float*)d_in[i];
    a.out = (float*)d_out; a.ws = (unsigned char*)d_ws;
    void* args[] = {&a};
    hipError_t e = hipLaunchCooperativeKernel((const void*)mk_fwd, dim3(grid), dim3(512), args, LDS_BYTES, stream);
    if (e != hipSuccess) fprintf(stderr, "cooperative launch failed: %s (grid %d)\n", hipGetErrorString(e), grid);
}
```

```cpp
#include <hip/hip_runtime.h>
#include <hip/hip_cooperative_groups.h>
#include <hip/hip_bf16.h>
#include <cstdio>
#include <cstdint>
#include <cmath>
namespace cg = cooperative_groups;

#define LAS __attribute__((address_space(3)))
#define GAS __attribute__((address_space(1)))
typedef unsigned short bf16_t;
typedef short bf16x8 __attribute__((ext_vector_type(8)));
typedef float f32x4 __attribute__((ext_vector_type(4)));
typedef float f32x2 __attribute__((ext_vector_type(2)));
typedef unsigned u32x4 __attribute__((ext_vector_type(4)));
typedef unsigned u32x2 __attribute__((ext_vector_type(2)));

constexpr int DM = 1024, NB = 8, SEQ = 4096, MROWS = NB * SEQ, DFF = 2816, NUP = 2 * DFF;
constexpr float LN_EPS = 1e-5f, RMS_EPS = 1e-6f;
constexpr float ALPHA = 1.681792830507429f;
constexpr float C2 = 0.125f * 1.4426950408889634f;
constexpr float LAMBDA_INIT2 = 0.47071301834358366f;

constexpr size_t MiB = 1u << 20;
constexpr size_t WS_WUP = 1 * MiB;
constexpr size_t WS_WDN = 45 * MiB;
constexpr size_t WS_QKV0 = 67 * MiB, WS_WO0 = 70 * MiB, WS_FWO = 72 * MiB, WS_QKV2 = 74 * MiB, WS_WO2 = 80 * MiB, WS_QKV3 = 82 * MiB, WS_WO3 = 85 * MiB;
constexpr size_t WS_TT = 87 * MiB;
constexpr size_t WS_AXC = 88 * MiB, WS_AXS = WS_AXC + 4096, WS_RC = WS_AXC + 65536, WS_RS = WS_RC + 131072;
constexpr size_t WS_XB = 90 * MiB;
constexpr size_t WS_R = 154 * MiB;
constexpr size_t WS_QKV = WS_R;
constexpr size_t WS_O_GQA = WS_R + 96 * MiB;
constexpr size_t WS_O12 = WS_R + 192 * MiB;
constexpr size_t WS_YT = WS_R + 64 * MiB;
constexpr size_t WS_XE = WS_R;
constexpr size_t WS_YCH = 88 * MiB + 512 * 1024;
constexpr size_t WS_A2 = WS_R + 294 * MiB;
constexpr size_t WS_G = WS_R;
constexpr size_t WS_E = WS_R + 176 * MiB;
constexpr size_t WS_XH7 = WS_R + 230 * MiB;
constexpr size_t WS_NEED = 512 * MiB;

constexpr int LDS_BYTES = 147456;

__device__ __forceinline__ float shx(float v, int lane, int m) { return __builtin_bit_cast(float, __builtin_amdgcn_ds_bpermute((lane ^ m) << 2, __builtin_bit_cast(int, v))); }
__device__ __forceinline__ float xsum16(float v) { auto r = __builtin_amdgcn_permlane16_swap(__float_as_uint(v), __float_as_uint(v), false, false); return __uint_as_float(r[0]) + __uint_as_float(r[1]); }
__device__ __forceinline__ float xsum32(float v) { auto r = __builtin_amdgcn_permlane32_swap(__float_as_uint(v), __float_as_uint(v), false, false); return __uint_as_float(r[0]) + __uint_as_float(r[1]); }
__device__ __forceinline__ float xpart16(float v, bool oddrow) { auto r = __builtin_amdgcn_permlane16_swap(__float_as_uint(v), __float_as_uint(v), false, false); return __uint_as_float(oddrow ? r[0] : r[1]); }
namespace pg8 {
constexpr int BM = 256, BK = 64, HALF = 128, HTB = HALF * BK * 2, NXCD = 8, WGM = 8;
__host__ __device__ __forceinline__ int lds_byte(int r, int c) { const int st = (r >> 4) * 2 + (c >> 5), rr = r & 15, cc = c & 31, ob = rr * 64 + cc * 2; return st * 1024 + (ob ^ (((ob >> 9) & 1) << 5)); }
__host__ __device__ __forceinline__ void stage_rc(int b, int& R, int& C) { const int st = b / 1024, sb = b % 1024, swz = sb ^ (((sb >> 9) & 1) << 5); R = (st >> 1) * 16 + swz / 64; C = (st & 1) * 32 + (swz % 64) / 2; }
__host__ __device__ __forceinline__ int perm32(int rho) { const int n = rho >> 4, i = rho & 15; return 8 * (i >> 2) + 4 * n + (i & 3); }

struct Unit { int pm, pn; };
struct StaticOrder {
    int nM, nN, nwg, G, c;
    __device__ void init(int nM_, int nN_, int G_, int c_) { nM = nM_; nN = nN_; nwg = nM * nN; G = G_; c = c_; }
    __device__ bool next(int i, Unit& u) const {
        const long L = (long)i * G + c; if (L >= nwg) return false;
        int wgid = (int)L; { const int q = nwg / NXCD, r = nwg % NXCD, xcd = wgid % NXCD, off = wgid / NXCD; wgid = (xcd < r ? xcd * (q + 1) : r * (q + 1) + (xcd - r) * q) + off; }
        const int nig = WGM * nN, gid = wgid / nig, fm = gid * WGM, gsz = (nM - fm) < WGM ? (nM - fm) : WGM;
        u.pm = fm + ((wgid % nig) % gsz); u.pn = (wgid % nig) / gsz; return true;
    }
};
__device__ __forceinline__ unsigned cvt_pk_f16(float lo, float hi) { unsigned r; asm volatile("v_cvt_pk_f16_f32 %0, %1, %2" : "=v"(r) : "v"(lo), "v"(hi)); return r; }
__device__ __forceinline__ unsigned cvt_pk_bf16(float lo, float hi) { unsigned r; asm volatile("v_cvt_pk_bf16_f32 %0, %1, %2" : "=v"(r) : "v"(lo), "v"(hi)); return r; }

struct MapStd { const char* A; const char* B; size_t lda2, ldb2;
    __device__ __forceinline__ void ptrs(const Unit& u, const char*& a, const char*& b) const { a = A + (size_t)u.pm * 256 * lda2; b = B + (size_t)u.pn * 256 * ldb2; } };
struct MapF1 { const char* Tt; const char* XE;
    __device__ __forceinline__ void ptrs(const Unit& u, const char*& a, const char*& b) const { a = Tt + (size_t)(u.pm & 1) * 256 * 512; b = XE + (size_t)(u.pm & 1) * (32u << 20) + (size_t)u.pn * 256 * 2048 + (size_t)(u.pm >> 1) * 512; } };
struct MapF2 { const char* A2; const char* YT;
    __device__ __forceinline__ void ptrs(const Unit& u, const char*& a, const char*& b) const { const size_t po = (size_t)((u.pm >> 3) & 1) * 4096;
        a = A2 + (size_t)(u.pm & 7) * 256 * 8192 + po; b = YT + (size_t)(u.pm >> 4) * (1024u * 8192u) + (size_t)u.pn * 256 * 8192 + po; } };

template <class T> __device__ __forceinline__ T gld(const GAS void* ub, unsigned boff) { return *(const GAS T*)((const GAS char*)ub + boff); }
template <class T> __device__ __forceinline__ void gst(GAS void* ub, unsigned boff, const T& v) { *(GAS T*)((GAS char*)ub + boff) = v; }
struct EpiResid { static constexpr bool PERM = false, APERM = false;
    const GAS float* X; GAS float* Y; const GAS float* bias;
    __device__ __forceinline__ void operator()(f32x4 (&acc)[2][2][4][2], const Unit& u, int wr, int wc, int lane) const {
        const int fr = lane & 15, fq = lane >> 4;
        const int colu = u.pn * BM + wc * 32;
        f32x4 bv[2][2];
#pragma unroll
        for (int bj = 0; bj < 2; ++bj)
#pragma unroll
            for (int n = 0; n < 2; ++n) bv[bj][n] = bias ? gld<f32x4>(bias + colu + bj * HALF + n * 16, 16u * fq) : (f32x4){0.f, 0.f, 0.f, 0.f};
#pragma unroll
        for (int ai = 0; ai < 2; ++ai) {
            const size_t uoff = (size_t)(u.pm * BM + ai * HALF + wr * 64) * DM + colu;
            const GAS float* xu = X + uoff; GAS float* yu = Y + uoff;
#pragma unroll
            for (int m = 0; m < 4; ++m) { const unsigned lo = (unsigned)((m * 16 + fr) * DM + 4 * fq) * 4u;
                f32x4 xv[2][2];
#pragma unroll
                for (int bj = 0; bj < 2; ++bj)
#pragma unroll
                    for (int n = 0; n < 2; ++n) xv[bj][n] = gld<f32x4>(xu + bj * HALF + n * 16, lo);
#pragma unroll
                for (int bj = 0; bj < 2; ++bj)
#pragma unroll
                    for (int n = 0; n < 2; ++n) gst<f32x4>(yu + bj * HALF + n * 16, lo, xv[bj][n] * ALPHA + acc[ai][bj][m][n] + bv[bj][n]);
                asm volatile("" ::: "memory"); }
        }
    }
};
struct PanelStats {
    unsigned* xbuf;
    unsigned* cnt;
    LAS unsigned char* tl;
    __device__ __forceinline__ void run(const f32x4 (&v)[2][2][4][2], const Unit& u, int wr, int wc, int lane) const {
        const int fr = lane & 15, fq = lane >> 4, wid = wr * 4 + wc;
        LAS f32x2* P = (LAS f32x2*)tl; LAS f32x2* S = (LAS f32x2*)(tl + 8192);
#pragma unroll
        for (int ai = 0; ai < 2; ++ai)
#pragma unroll
            for (int m = 0; m < 4; ++m) {
                float s = 0.f;
#pragma unroll
                for (int bj = 0; bj < 2; ++bj)
#pragma unroll
                    for (int n = 0; n < 2; ++n) { const f32x4 x = v[ai][bj][m][n]; s += (x[0] + x[1]) + (x[2] + x[3]); }
                s = xsum32(xsum16(s));
                const float mw = s * (1.0f / 64.0f); float q = 0.f;
#pragma unroll
                for (int bj = 0; bj < 2; ++bj)
#pragma unroll
                    for (int n = 0; n < 2; ++n) { const f32x4 d = v[ai][bj][m][n] - mw; q += (d[0] * d[0] + d[1] * d[1]) + (d[2] * d[2] + d[3] * d[3]); }
                q = xsum32(xsum16(q));
                if (fq == 0) P[(ai * HALF + wr * 64 + m * 16 + fr) * 4 + wc] = (f32x2){mw, q};
            }
        asm volatile("s_waitcnt lgkmcnt(0)" ::: "memory"); __builtin_amdgcn_s_barrier(); asm volatile("" ::: "memory");
        const int row = wid * 32 + (lane & 31);
        if (lane < 32) {
            const f32x2 a = P[row * 4 + 0], b = P[row * 4 + 1], c = P[row * 4 + 2], d = P[row * 4 + 3];
            const float mt = (a.x + b.x + c.x + d.x) * 0.25f;
            const float da = a.x - mt, db = b.x - mt, dc = c.x - mt, dd = d.x - mt;
            const float m2 = (a.y + b.y) + (c.y + d.y) + 64.0f * ((da * da + db * db) + (dc * dc + dd * dd));
            unsigned long long* slot = (unsigned long long*)xbuf + ((size_t)(u.pm * BM + row) * 4 + u.pn);
            __hip_atomic_store(slot, ((unsigned long long)__float_as_uint(m2) << 32) | __float_as_uint(mt), __ATOMIC_RELAXED, __HIP_MEMORY_SCOPE_AGENT);
        }
        asm volatile("s_waitcnt vmcnt(0)" ::: "memory");
        if (lane == 0) __hip_atomic_fetch_add(cnt + 64 * u.pm, 1u, __ATOMIC_RELAXED, __HIP_MEMORY_SCOPE_AGENT);
        if (wid == 0) {
            unsigned sp = 0;
            for (;;) {
                if ((unsigned)__builtin_amdgcn_readfirstlane(__hip_atomic_load(cnt + 64 * u.pm, __ATOMIC_RELAXED, __HIP_MEMORY_SCOPE_AGENT)) >= 32u) break;
                if (++sp > (1u << 24)) break;
                __builtin_amdgcn_s_sleep(2);
            }
            __builtin_amdgcn_fence(__ATOMIC_ACQUIRE, "agent");
        }
        asm volatile("s_waitcnt vmcnt(0) lgkmcnt(0)" ::: "memory"); __builtin_amdgcn_s_barrier(); asm volatile("" ::: "memory");
        if (lane < 32) {
            const unsigned long long* slot = (const unsigned long long*)xbuf + (size_t)(u.pm * BM + row) * 4; float mt[4], m2[4]; float ms = 0.f;
#pragma unroll
            for (int t = 0; t < 4; ++t) { const unsigned long long w = __hip_atomic_load(slot + t, __ATOMIC_RELAXED, __HIP_MEMORY_SCOPE_AGENT); mt[t] = __uint_as_float((unsigned)w); m2[t] = __uint_as_float((unsigned)(w >> 32)); ms += mt[t]; }
            const float mean = ms * 0.25f; float q = 0.f;
#pragma unroll
            for (int t = 0; t < 4; ++t) { const float dm = mt[t] - mean; q += m2[t] + 256.0f * dm * dm; }
            S[row] = (f32x2){mean, 1.0f / sqrtf(q * (1.0f / 1024.0f) + LN_EPS)};
        }
        asm volatile("s_waitcnt lgkmcnt(0)" ::: "memory"); __builtin_amdgcn_s_barrier(); asm volatile("" ::: "memory");
    }
};
struct EpiResidLn { static constexpr bool PERM = true, APERM = false;
    GAS float* Y; GAS bf16_t* XBo; const GAS bf16_t* XHr; GAS bf16_t* XHw; const GAS float* bias; const GAS float* g; const GAS float* b; PanelStats st; bool xbf;
    static __device__ __forceinline__ float h2f(unsigned short hbits) { return (float)__builtin_bit_cast(_Float16, hbits); }
    __device__ __forceinline__ void operator()(f32x4 (&acc)[2][2][4][2], const Unit& u, int wr, int wc, int lane) const {
        const int fr = lane & 15, fq = lane >> 4;
        const int colu = u.pn * BM + wc * 32;
        {
            f32x4 bv[2][2];
#pragma unroll
            for (int bj = 0; bj < 2; ++bj)
#pragma unroll
                for (int n = 0; n < 2; ++n) bv[bj][n] = bias ? gld<f32x4>(bias + colu + bj * HALF + n * 4, 32u * fq) : (f32x4){0.f, 0.f, 0.f, 0.f};
#pragma unroll
            for (int ai = 0; ai < 2; ++ai) {
                const GAS bf16_t* xu = XHr + (size_t)(u.pm * BM + ai * HALF + wr * 64) * DM + colu;
#pragma unroll
                for (int m = 0; m < 4; ++m) { const unsigned lo = (unsigned)((m * 16 + fr) * DM + 8 * fq) * 2u;
                    u32x4 xw[2];
#pragma unroll
                    for (int bj = 0; bj < 2; ++bj) xw[bj] = gld<u32x4>(xu + bj * HALF, lo);
#pragma unroll
                    for (int bj = 0; bj < 2; ++bj)
#pragma unroll
                        for (int n = 0; n < 2; ++n) { const unsigned w0 = xw[bj][2 * n], w1 = xw[bj][2 * n + 1];
                            const f32x4 xv = xbf ? (f32x4){__uint_as_float(w0 << 16), __uint_as_float(w0 & 0xffff0000u), __uint_as_float(w1 << 16), __uint_as_float(w1 & 0xffff0000u)}
                                                 : (f32x4){h2f((unsigned short)(w0 & 0xffffu)), h2f((unsigned short)(w0 >> 16)), h2f((unsigned short)(w1 & 0xffffu)), h2f((unsigned short)(w1 >> 16))};
                            acc[ai][bj][m][n] = xv * ALPHA + acc[ai][bj][m][n] + bv[bj][n]; }
                    asm volatile("" : "+v"(acc[ai][0][m][0]), "+v"(acc[ai][0][m][1]), "+v"(acc[ai][1][m][0]), "+v"(acc[ai][1][m][1]));
                    if (m & 1) asm volatile("" ::: "memory"); }
            }
        }
        st.run(acc, u, wr, wc, lane);
        const LAS f32x2* S = (const LAS f32x2*)(st.tl + 8192);
        f32x4 gv[2][2], bb[2][2];
#pragma unroll
        for (int bj = 0; bj < 2; ++bj)
#pragma unroll
            for (int n = 0; n < 2; ++n) { gv[bj][n] = gld<f32x4>(g + colu + bj * HALF + n * 4, 32u * fq); bb[bj][n] = gld<f32x4>(b + colu + bj * HALF + n * 4, 32u * fq); }
#pragma unroll
        for (int ai = 0; ai < 2; ++ai) {
            const size_t uoff = (size_t)(u.pm * BM + ai * HALF + wr * 64) * DM + colu;
            GAS float* yu = Y + uoff; GAS bf16_t* bu = XBo + uoff; GAS bf16_t* hu = XHw + uoff;
#pragma unroll
            for (int m = 0; m < 4; ++m) { const int r = ai * HALF + wr * 64 + m * 16 + fr; const f32x2 sr = S[r];
                const unsigned lo = (unsigned)((m * 16 + fr) * DM + 8 * fq);
#pragma unroll
                for (int bj = 0; bj < 2; ++bj) {
                    const f32x4 o0 = (acc[ai][bj][m][0] - sr.x) * sr.y * gv[bj][0] + bb[bj][0], o1 = (acc[ai][bj][m][1] - sr.x) * sr.y * gv[bj][1] + bb[bj][1];
                    if (Y) { gst<f32x4>(yu + bj * HALF, lo * 4u, o0); gst<f32x4>(yu + bj * HALF + 4, lo * 4u, o1); }
                    if (XHw) { u32x4 wh; wh.x = cvt_pk_f16(o0[0], o0[1]); wh.y = cvt_pk_f16(o0[2], o0[3]); wh.z = cvt_pk_f16(o1[0], o1[1]); wh.w = cvt_pk_f16(o1[2], o1[3]); gst<u32x4>(hu + bj * HALF, lo * 2u, wh); }
                    if (XBo) { u32x4 w; w.x = cvt_pk_bf16(o0[0], o0[1]); w.y = cvt_pk_bf16(o0[2], o0[3]); w.z = cvt_pk_bf16(o1[0], o1[1]); w.w = cvt_pk_bf16(o1[2], o1[3]); gst<u32x4>(bu + bj * HALF, lo * 2u, w); } }
            }
        }
    }
};
template <int MODE> struct EpiBf16 { static constexpr bool PERM = true, APERM = false;
    GAS bf16_t* O; float scale; const GAS float* corr;
    __device__ __forceinline__ void operator()(f32x4 (&acc)[2][2][4][2], const Unit& u, int wr, int wc, int lane) const {
        const int fr = lane & 15, fq = lane >> 4;
        size_t base; constexpr unsigned ldc = MODE == 0 ? DM : 4096;
        if (MODE == 0) { base = (size_t)(u.pm * BM) * DM + u.pn * BM; }
        else { const int g = u.pm >> 1, part = u.pm & 1, b = u.pn >> 3, st = u.pn & 7; base = ((size_t)b * 1024 + g * 256) * 4096 + (size_t)part * 2048 + st * 256; }
        GAS bf16_t* ou = O + base + (size_t)(wr * 64) * ldc + wc * 32;
        f32x4 cv[2][2];
#pragma unroll
        for (int bj = 0; bj < 2; ++bj)
#pragma unroll
            for (int n = 0; n < 2; ++n) { cv[bj][n] = (f32x4){0.f, 0.f, 0.f, 0.f};
                if (MODE == 0) { cv[bj][n] = gld<f32x4>(corr + (size_t)(u.pm >> 4) * 1024 + u.pn * BM + bj * HALF + wc * 32 + 4 * n, 32u * fq); if (fr & 1) cv[bj][n] = -cv[bj][n]; } }
#pragma unroll
        for (int ai = 0; ai < 2; ++ai)
#pragma unroll
            for (int m = 0; m < 4; ++m) { const unsigned lo = ((unsigned)(fr + ai * HALF + m * 16) * ldc + 8u * fq) * 2u;
#pragma unroll
                for (int bj = 0; bj < 2; ++bj) { const f32x4 v0 = (acc[ai][bj][m][0] + cv[bj][0]) * scale, v1 = (acc[ai][bj][m][1] + cv[bj][1]) * scale;
                    u32x4 w; w.x = cvt_pk_bf16(v0[0], v0[1]); w.y = cvt_pk_bf16(v0[2], v0[3]); w.z = cvt_pk_bf16(v1[0], v1[1]); w.w = cvt_pk_bf16(v1[2], v1[3]);
                    gst<u32x4>(ou + bj * HALF, lo, w); } }
    }
};
struct EpiF2s { static constexpr bool PERM = true, APERM = false;
    GAS bf16_t* Z; float scale; const GAS float* corr; GAS float* PS;
    __device__ __forceinline__ void operator()(f32x4 (&acc)[2][2][4][2], const Unit& u, int wr, int wc, int lane) const {
        const int fr = lane & 15, fq = lane >> 4;
        const int b = u.pm >> 4, part = (u.pm >> 3) & 1, kt = u.pm & 7;
        GAS float* ps = PS + (size_t)blockIdx.x * (32 * 512 * 4);
        const unsigned lops = (unsigned)((wr * 4 + wc) * 64 + lane) * 16u;
        if (part == 0) {
#pragma unroll
            for (int ai = 0; ai < 2; ++ai)
#pragma unroll
                for (int bj = 0; bj < 2; ++bj)
#pragma unroll
                    for (int m = 0; m < 4; ++m)
#pragma unroll
                        for (int n = 0; n < 2; ++n) gst<f32x4>(ps + (((ai * 2 + bj) * 4 + m) * 2 + n) * 2048, lops, acc[ai][bj][m][n]);
            return;
        }
        asm volatile("s_waitcnt vmcnt(0)" ::: "memory");
        f32x4 cv[2][2];
#pragma unroll
        for (int bj = 0; bj < 2; ++bj)
#pragma unroll
            for (int n = 0; n < 2; ++n) { cv[bj][n] = gld<f32x4>(corr + (size_t)b * 1024 + u.pn * BM + bj * HALF + wc * 32 + 4 * n, 32u * fq); if (fr & 1) cv[bj][n] = -cv[bj][n]; }
        GAS bf16_t* zu = Z + (size_t)b * SEQ * DM + u.pn * BM + wc * 32;
#pragma unroll
        for (int ai = 0; ai < 2; ++ai)
#pragma unroll
            for (int m = 0; m < 4; ++m) {
                const int k = kt * 256 + ai * HALF + wr * 64 + m * 16 + fr;
                const unsigned lo1 = ((unsigned)k * DM + 8u * fq) * 2u, lo2 = ((unsigned)(SEQ - k) * DM + 8u * fq) * 2u;
#pragma unroll
                for (int bj = 0; bj < 2; ++bj) {
                    const f32x4 c0 = gld<f32x4>(ps + (((ai * 2 + bj) * 4 + m) * 2 + 0) * 2048, lops) + cv[bj][0], c1 = gld<f32x4>(ps + (((ai * 2 + bj) * 4 + m) * 2 + 1) * 2048, lops) + cv[bj][1];
                    const f32x4 s0 = acc[ai][bj][m][0], s1 = acc[ai][bj][m][1];
                    const f32x4 p0 = (c0 + s0) * scale, p1 = (c1 + s1) * scale, q0 = (c0 - s0) * scale, q1 = (c1 - s1) * scale;
                    u32x4 w; w.x = cvt_pk_bf16(p0[0], p0[1]); w.y = cvt_pk_bf16(p0[2], p0[3]); w.z = cvt_pk_bf16(p1[0], p1[1]); w.w = cvt_pk_bf16(p1[2], p1[3]);
                    gst<u32x4>(zu + bj * HALF, lo1, w);
                    if (k != 0) { u32x4 v; v.x = cvt_pk_bf16(q0[0], q0[1]); v.y = cvt_pk_bf16(q0[2], q0[3]); v.z = cvt_pk_bf16(q1[0], q1[1]); v.w = cvt_pk_bf16(q1[2], q1[3]);
                        gst<u32x4>(zu + bj * HALF, lo2, v); }
                }
            }
    }
};
struct EpiQkvGqa { static constexpr bool PERM = true, APERM = false;
    GAS bf16_t* O; const GAS float* qg; const GAS float* kg; const GAS float* axc; const GAS float* axs;
    __device__ __forceinline__ void operator()(f32x4 (&acc)[2][2][4][2], const Unit& u, int wr, int wc, int lane) const {
        const int fr = lane & 15, fq = lane >> 4;
        const bool isv = u.pn == 5, isq = u.pn < 4;
        const GAS float* gp = isq ? qg : kg;
        const int dl = 32 * (fq >> 1) + 8 * (fq & 1);
        f32x4 gv[2][2];
#pragma unroll
        for (int bj = 0; bj < 2; ++bj)
#pragma unroll
            for (int n = 0; n < 2; ++n) gv[bj][n] = gld<f32x4>(gp + 16 * bj + 4 * n, 4u * dl);
        const float osc = isq ? C2 : 1.0f;
#pragma unroll
        for (int ai = 0; ai < 2; ++ai) {
            const int rowu = u.pm * BM + ai * HALF + wr * 64;
            GAS bf16_t* ou = O + (size_t)rowu * 1536 + u.pn * 256 + wc * 64;
#pragma unroll
            for (int m = 0; m < 4; ++m) {
                const unsigned lo = ((unsigned)(m * 16 + fr) * 1536u + (unsigned)dl) * 2u;
                f32x4 v[2][2];
#pragma unroll
                for (int bj = 0; bj < 2; ++bj)
#pragma unroll
                    for (int n = 0; n < 2; ++n) v[bj][n] = acc[ai][bj][m][n];
                if (!isv) {
                    float ss = 0.f;
#pragma unroll
                    for (int bj = 0; bj < 2; ++bj)
#pragma unroll
                        for (int n = 0; n < 2; ++n) ss += (v[bj][n][0] * v[bj][n][0] + v[bj][n][1] * v[bj][n][1]) + (v[bj][n][2] * v[bj][n][2] + v[bj][n][3] * v[bj][n][3]);
                    ss = xsum32(xsum16(ss));
                    const float rinv = 1.0f / sqrtf(ss * (1.0f / 64.0f) + RMS_EPS);
                    const int s = (rowu + m * 16 + fr) & (SEQ - 1);
                    const int t = (fq >> 1) == 0 ? (s >> 6) : (s & 63);
#pragma unroll
                    for (int n = 0; n < 2; ++n) {
                        const unsigned to = (unsigned)(t * 16 + 8 * (fq & 1) + 4 * n) * 4u;
                        const f32x4 c = gld<f32x4>(axc, to), sn = gld<f32x4>(axs, to);
                        const f32x4 x1 = v[0][n] * rinv * gv[0][n], x2 = v[1][n] * rinv * gv[1][n];
                        v[0][n] = (x1 * c - x2 * sn) * osc; v[1][n] = (x2 * c + x1 * sn) * osc;
                    }
                }
#pragma unroll
                for (int bj = 0; bj < 2; ++bj) { u32x4 w; w.x = cvt_pk_bf16(v[bj][0][0], v[bj][0][1]); w.y = cvt_pk_bf16(v[bj][0][2], v[bj][0][3]); w.z = cvt_pk_bf16(v[bj][1][0], v[bj][1][1]); w.w = cvt_pk_bf16(v[bj][1][2], v[bj][1][3]);
                    gst<u32x4>(ou + 16 * bj, lo, w); }
            }
        }
    }
};
struct EpiQkvDiff { static constexpr bool PERM = true, APERM = false;
    GAS bf16_t* O; const GAS float* rc; const GAS float* rs;
    __device__ __forceinline__ void operator()(f32x4 (&acc)[2][2][4][2], const Unit& u, int wr, int wc, int lane) const {
        const int fr = lane & 15, fq = lane >> 4;
        const bool ropesel = (u.pn < 8) && ((wc & 1) == 0);
        const bool rope = ropesel && (fq < 2);
        const float osc = (u.pn < 4) ? C2 : 1.0f;
#pragma unroll
        for (int ai = 0; ai < 2; ++ai) {
            const int rowu = u.pm * BM + ai * HALF + wr * 64;
            GAS bf16_t* ou = O + (size_t)rowu * 3072 + u.pn * BM + wc * 32;
#pragma unroll
            for (int m = 0; m < 4; ++m) {
                const unsigned lo = ((unsigned)(m * 16 + fr) * 3072u + 8u * fq) * 2u;
                const int s = (rowu + m * 16 + fr) & (SEQ - 1);
#pragma unroll
                for (int bj = 0; bj < 2; ++bj) {
                    f32x4 v0 = acc[ai][bj][m][0], v1 = acc[ai][bj][m][1];
                    if (ropesel) {
                        f32x4 p0, p1;
#pragma unroll
                        for (int j = 0; j < 4; ++j) { p0[j] = xpart16(v0[j], (fq & 1) != 0); p1[j] = xpart16(v1[j], (fq & 1) != 0); }
                        if (rope) {
                            const f32x4 ca = gld<f32x4>(rc, (unsigned)s * 32u), cb = gld<f32x4>(rc + 4, (unsigned)s * 32u), sa = gld<f32x4>(rs, (unsigned)s * 32u), sb = gld<f32x4>(rs + 4, (unsigned)s * 32u);
                            if (fq == 0) { v0 = v0 * ca - p0 * sa; v1 = v1 * cb - p1 * sb; }
                            else { v0 = v0 * ca + p0 * sa; v1 = v1 * cb + p1 * sb; }
                        }
                    }
                    v0 = v0 * osc; v1 = v1 * osc;
                    u32x4 w; w.x = cvt_pk_bf16(v0[0], v0[1]); w.y = cvt_pk_bf16(v0[2], v0[3]); w.z = cvt_pk_bf16(v1[0], v1[1]); w.w = cvt_pk_bf16(v1[2], v1[3]);
                    gst<u32x4>(ou + bj * HALF, lo, w);
                }
            }
        }
    }
};
__device__ __forceinline__ float dpp_ror1(float x) { return __builtin_bit_cast(float, __builtin_amdgcn_mov_dpp(__builtin_bit_cast(int, x), 0x121, 0xf, 0xf, true)); }
__device__ __forceinline__ float dpp_ror15(float x) { return __builtin_bit_cast(float, __builtin_amdgcn_mov_dpp(__builtin_bit_cast(int, x), 0x12F, 0xf, 0xf, true)); }
__device__ __forceinline__ float silu_mul(float g, float v) { return g * v * __builtin_amdgcn_rcpf(1.0f + __builtin_amdgcn_exp2f(-1.4426950408889634f * g)); }
struct EpiUpConv { static constexpr bool PERM = true, APERM = true;
    GAS bf16_t* G; GAS bf16_t* E; const GAS float* cw; const GAS float* cb;
    __device__ __forceinline__ void conv4(const f32x4& a0, const f32x4& a1, const f32x4& a2, const f32x4& a3, const f32x4& w0, const f32x4& w1, const f32x4& w2, const f32x4& b, f32x2 (&h)[4][2]) const {
#pragma unroll
        for (int p = 0; p < 2; ++p) {
            float u0, u1, d0, d1;
            asm volatile("s_nop 1\n\tv_mov_b32_dpp %0, %1 row_shr:1 row_mask:0xf bank_mask:0xf bound_ctrl:1" : "=&v"(u0) : "v"(a3[2 * p]));
            asm volatile("s_nop 1\n\tv_mov_b32_dpp %0, %1 row_shr:1 row_mask:0xf bank_mask:0xf bound_ctrl:1" : "=&v"(u1) : "v"(a3[2 * p + 1]));
            asm volatile("s_nop 1\n\tv_mov_b32_dpp %0, %1 row_shl:1 row_mask:0xf bank_mask:0xf bound_ctrl:1" : "=&v"(d0) : "v"(a0[2 * p]));
            asm volatile("s_nop 1\n\tv_mov_b32_dpp %0, %1 row_shl:1 row_mask:0xf bank_mask:0xf bound_ctrl:1" : "=&v"(d1) : "v"(a0[2 * p + 1]));
            const f32x2 UP = {u0, u1}, DN = {d0, d1};
            const f32x2 A0 = {a0[2 * p], a0[2 * p + 1]}, A1 = {a1[2 * p], a1[2 * p + 1]}, A2 = {a2[2 * p], a2[2 * p + 1]}, A3 = {a3[2 * p], a3[2 * p + 1]};
            const f32x2 W0 = {w0[2 * p], w0[2 * p + 1]}, W1 = {w1[2 * p], w1[2 * p + 1]}, W2 = {w2[2 * p], w2[2 * p + 1]}, B = {b[2 * p], b[2 * p + 1]};
            h[0][p] = B + W0 * UP + W1 * A0 + W2 * A1;
            h[1][p] = B + W0 * A0 + W1 * A1 + W2 * A2;
            h[2][p] = B + W0 * A1 + W1 * A2 + W2 * A3;
            h[3][p] = B + W0 * A2 + W1 * A3 + W2 * DN;
        }
    }
    static __device__ __forceinline__ unsigned silu_pk(const f32x2 g, const f32x2 v) {
        const f32x2 t = g * -1.4426950408889634f;
        const f32x2 d = (f32x2){__builtin_amdgcn_exp2f(t.x), __builtin_amdgcn_exp2f(t.y)} + 1.0f;
        const f32x2 o = g * v * (f32x2){__builtin_amdgcn_rcpf(d.x), __builtin_amdgcn_rcpf(d.y)};
        return cvt_pk_bf16(o.x, o.y);
    }
    __device__ __forceinline__ void operator()(f32x4 (&acc)[2][2][4][2], const Unit& u, int wr, int wc, int lane) const {
        const int fr = lane & 15, fq = lane >> 4;
        const int colu = u.pn * 128 + wc * 32;
        const GAS float* cwu = cw + colu; const GAS float* cbu = cb + colu;
        u32x2 keep[2][4];
        u32x2 ekeep[2][2][2];
        f32x4 wgt[2][8];
#pragma unroll
        for (int n = 0; n < 2; ++n) { const unsigned co = (unsigned)(8 * fq + 4 * n) * 4u;
            wgt[n][0] = gld<f32x4>(cwu, co); wgt[n][1] = gld<f32x4>(cwu + NUP, co); wgt[n][2] = gld<f32x4>(cwu + 2 * NUP, co); wgt[n][3] = gld<f32x4>(cbu, co);
            wgt[n][4] = gld<f32x4>(cwu + DFF, co); wgt[n][5] = gld<f32x4>(cwu + NUP + DFF, co); wgt[n][6] = gld<f32x4>(cwu + 2 * NUP + DFF, co); wgt[n][7] = gld<f32x4>(cbu + DFF, co); }
#pragma unroll
        for (int n = 0; n < 2; ++n) {
            const f32x4 wg0 = wgt[n][0], wg1 = wgt[n][1], wg2 = wgt[n][2], bg = wgt[n][3], wv0 = wgt[n][4], wv1 = wgt[n][5], wv2 = wgt[n][6], bvv = wgt[n][7];
#pragma unroll
            for (int ai = 0; ai < 2; ++ai) {
                const int blk = 4 * u.pm + 2 * ai + wr;
                GAS bf16_t* gu = G + (size_t)(u.pm * BM + ai * HALF + wr * 64) * DFF + colu;
                GAS bf16_t* eu = E + (size_t)blk * 4 * NUP + colu;
                f32x2 hg[4][2], hv[4][2];
                conv4(acc[ai][0][0][n], acc[ai][0][1][n], acc[ai][0][2][n], acc[ai][0][3][n], wg0, wg1, wg2, bg, hg);
                conv4(acc[ai][1][0][n], acc[ai][1][1][n], acc[ai][1][2][n], acc[ai][1][3][n], wv0, wv1, wv2, bvv, hv);
#pragma unroll
                for (int m = 0; m < 4; ++m) {
                    u32x2 w; w.x = silu_pk(hg[m][0], hv[m][0]); w.y = silu_pk(hg[m][1], hv[m][1]);
                    if (n == 0) keep[ai][m] = w;
                    else { u32x4 w4; w4.x = keep[ai][m].x; w4.y = keep[ai][m].y; w4.z = w.x; w4.w = w.y; gst<u32x4>(gu, ((unsigned)(4 * fr + m) * DFF + 8u * fq) * 2u, w4); }
                }
                if (fr == 0 || fr == 15) {
                    const int mb = fr == 0 ? 0 : 2;
#pragma unroll
                    for (int e = 0; e < 2; ++e) {
                        const f32x4 eg = fr == 0 ? acc[ai][0][e][n] : acc[ai][0][2 + e][n], ev = fr == 0 ? acc[ai][1][e][n] : acc[ai][1][2 + e][n];
                        const u32x2 pg = (u32x2){cvt_pk_f16(eg[0], eg[1]), cvt_pk_f16(eg[2], eg[3])}, pv = (u32x2){cvt_pk_f16(ev[0], ev[1]), cvt_pk_f16(ev[2], ev[3])};
                        if (n == 0) { ekeep[ai][e][0] = pg; ekeep[ai][e][1] = pv; }
                        else { const unsigned eo = ((unsigned)(mb + e) * NUP + 8u * fq) * 2u;
                            gst<u32x4>(eu, eo, (u32x4){ekeep[ai][e][0].x, ekeep[ai][e][0].y, pg.x, pg.y}); gst<u32x4>(eu + DFF, eo, (u32x4){ekeep[ai][e][1].x, ekeep[ai][e][1].y, pv.x, pv.y}); }
                    }
                }
            }
        }
    }
};

template <class Epi, class Map, bool ALIGN_EPI>
__device__ __forceinline__ void gemm_phase(const int tid, LAS unsigned char* lds, const int lda, const int ldb, const int K, const Map& MP, const StaticOrder& S, const Epi& E) {
    const int wid = __builtin_amdgcn_readfirstlane(tid >> 6), lane = tid & 63, wr = wid >> 2, wc = wid & 3, fr = lane & 15, fq = lane >> 4;
    const int nt = K / BK;
    unsigned voA, voB;
    { int R, C; stage_rc(tid * 16, R, C); const int Rb = Epi::PERM ? ((R & ~31) + perm32(R & 31)) : R;
      const int Ra = Epi::APERM ? ((R & ~63) + 4 * (R & 15) + ((R >> 4) & 3)) : R;
      voA = (unsigned)(Ra * lda + C) * 2u; voB = (unsigned)(Rb * ldb + C) * 2u; }
    const size_t r64A = (size_t)64 * lda * 2, r64B = (size_t)64 * ldb * 2;
    const size_t kstep = (size_t)(BK * 2);
    const size_t hstepA = (size_t)HALF * lda * 2, hstepB = (size_t)HALF * ldb * 2;
    const unsigned ldsw = (unsigned)wid * 1024u;
    const int aoff = lds_byte(wr * 64 + fr, fq * 8), boff = lds_byte(wc * 32 + fr, fq * 8);
#define PG8_SA(b, h) (((b) * 2 + (h)) * HTB)
#define PG8_SB(b, h) ((4 + (b) * 2 + (h)) * HTB)
#define PG8_STAGE(bufoff, gbase, voff) do { _Pragma("unroll") for (int _i = 0; _i < 2; ++_i) \
        __builtin_amdgcn_global_load_lds((const GAS unsigned*)((const GAS char*)(gbase) + (size_t)_i * r64##voff + (vo##voff)), (LAS unsigned*)(lds + (bufoff) + ldsw + _i * 8192), 16, 0, 0); } while (0)
#define PG8_LDA(dst, b, h) do { _Pragma("unroll") for (int m = 0; m < 4; ++m) _Pragma("unroll") for (int k = 0; k < 2; ++k) dst[m][k] = *(const LAS bf16x8*)(lds + PG8_SA(b, h) + aoff + m * 2048 + k * 1024); } while (0)
#define PG8_LDB(dst, b, h) do { _Pragma("unroll") for (int n = 0; n < 2; ++n) _Pragma("unroll") for (int k = 0; k < 2; ++k) dst[n][k] = *(const LAS bf16x8*)(lds + PG8_SB(b, h) + boff + n * 2048 + k * 1024); } while (0)
#define PG8_MMA(ai, bj, At, Bt) do { __builtin_amdgcn_s_setprio(1); _Pragma("unroll") for (int m = 0; m < 4; ++m) _Pragma("unroll") for (int n = 0; n < 2; ++n) _Pragma("unroll") for (int k = 0; k < 2; ++k) \
        acc[ai][bj][m][n] = __builtin_amdgcn_mfma_f32_16x16x32_bf16(Bt[n][k], At[m][k], acc[ai][bj][m][n], 0, 0, 0); __builtin_amdgcn_s_setprio(0); } while (0)
#define PG8_WAIT_V(n) asm volatile("s_waitcnt vmcnt(" #n ")" ::: "memory")
#define PG8_WAIT_L(n) asm volatile("s_waitcnt lgkmcnt(" #n ")" ::: "memory")
#define PG8_BAR __builtin_amdgcn_s_barrier()
#define PG8_SCHED __builtin_amdgcn_sched_barrier(0)
    Unit cur, nxt; int ui = 0;
    if (!S.next(0, cur)) return;
    f32x4 acc[2][2][4][2];
#pragma unroll
    for (int a = 0; a < 2; ++a)
#pragma unroll
        for (int b = 0; b < 2; ++b)
#pragma unroll
            for (int m = 0; m < 4; ++m)
#pragma unroll
                for (int n = 0; n < 2; ++n) acc[a][b][m][n] = (f32x4){0.f, 0.f, 0.f, 0.f};
    bf16x8 At[4][2], B0[2][2], B1[2][2];
    const char* cA; const char* cB; MP.ptrs(cur, cA, cB);
    PG8_STAGE(PG8_SB(0, 0), cB, B); PG8_STAGE(PG8_SB(0, 1), cB + hstepB, B); PG8_STAGE(PG8_SA(0, 0), cA, A); PG8_STAGE(PG8_SA(0, 1), cA + hstepA, A);
    if (wr == 1) PG8_BAR;
    PG8_WAIT_V(2); PG8_BAR;
    PG8_STAGE(PG8_SB(1, 0), cB + kstep, B); PG8_STAGE(PG8_SA(1, 0), cA + kstep, A); PG8_STAGE(PG8_SB(1, 1), cB + hstepB + kstep, B);
    PG8_WAIT_V(6); PG8_BAR;
    for (;;) {
        const bool has_next = S.next(ui + 1, nxt);
        const char* nA = cA; const char* nB = cB; if (has_next) MP.ptrs(nxt, nA, nB);
        for (int t = 0; t < nt; t += 2) {
            const bool last = (t == nt - 2);
            const char* a1 = cA + (size_t)(t + 1) * kstep;
            const char* a2 = last ? nA : cA + (size_t)(t + 2) * kstep; const char* b2 = last ? nB : cB + (size_t)(t + 2) * kstep;
            const char* a3 = a2 + kstep; const char* b3 = b2 + kstep;
            PG8_LDB(B0, 0, 0); PG8_LDB(B1, 0, 1); PG8_SCHED; PG8_LDA(At, 0, 0); PG8_STAGE(PG8_SA(1, 1), a1 + hstepA, A);
            PG8_WAIT_V(8); PG8_WAIT_L(0); PG8_BAR; PG8_MMA(0, 0, At, B0); PG8_MMA(0, 1, At, B1); PG8_BAR; PG8_SCHED;
            PG8_LDA(At, 0, 1); PG8_STAGE(PG8_SB(0, 0), b2, B); PG8_STAGE(PG8_SB(0, 1), b2 + hstepB, B); PG8_STAGE(PG8_SA(0, 0), a2, A);
            PG8_WAIT_V(8); PG8_WAIT_L(0); PG8_BAR; PG8_MMA(1, 0, At, B0); PG8_MMA(1, 1, At, B1); PG8_BAR; PG8_SCHED;
            PG8_LDB(B0, 1, 0); PG8_LDB(B1, 1, 1); PG8_SCHED; PG8_LDA(At, 1, 0); PG8_STAGE(PG8_SA(0, 1), a2 + hstepA, A);
            PG8_WAIT_V(8); PG8_WAIT_L(0); PG8_BAR; PG8_MMA(0, 0, At, B0); PG8_MMA(0, 1, At, B1); PG8_BAR; PG8_SCHED;
            PG8_LDA(At, 1, 1); PG8_STAGE(PG8_SB(1, 0), b3, B); PG8_STAGE(PG8_SB(1, 1), b3 + hstepB, B); PG8_STAGE(PG8_SA(1, 0), a3, A);
            PG8_WAIT_V(8); PG8_WAIT_L(0); PG8_BAR; PG8_MMA(1, 0, At, B0); PG8_MMA(1, 1, At, B1); PG8_BAR; PG8_SCHED;
        }
        if constexpr (ALIGN_EPI) { if (wr == 0) PG8_BAR; }
        { int ln_; asm volatile("v_mbcnt_lo_u32_b32 %0, -1, 0\n\tv_mbcnt_hi_u32_b32 %0, -1, %0" : "=v"(ln_)); E(acc, cur, wr, wc, ln_); }
        if (!has_next) break;
#pragma unroll
        for (int a = 0; a < 2; ++a)
#pragma unroll
            for (int b = 0; b < 2; ++b)
#pragma unroll
                for (int m = 0; m < 4; ++m)
#pragma unroll
                    for (int n = 0; n < 2; ++n) acc[a][b][m][n] = (f32x4){0.f, 0.f, 0.f, 0.f};
        cur = nxt; cA = nA; cB = nB; ++ui;
        if constexpr (ALIGN_EPI) { if (wr == 1) PG8_BAR; }
    }
    PG8_WAIT_V(0);
    if constexpr (!ALIGN_EPI) { if (wr == 0) PG8_BAR; }
    PG8_BAR;
#undef PG8_SA
#undef PG8_SB
#undef PG8_STAGE
#undef PG8_LDA
#undef PG8_LDB
#undef PG8_MMA
#undef PG8_WAIT_V
#undef PG8_WAIT_L
#undef PG8_BAR
#undef PG8_SCHED
}
}

namespace attn_body {
using bf16 = __hip_bfloat16;
using s16x4 = __attribute__((ext_vector_type(4))) short;
using f32x16 = __attribute__((ext_vector_type(16))) float;
constexpr int D = 64, NW = 8, QBLK = 32, QB = QBLK * NW, KVBLK = 64;
__device__ __forceinline__ int crow(int r, int hi) { return (r & 3) + 8 * (r >> 2) + 4 * hi; }
#define SBAR() __builtin_amdgcn_sched_barrier(0)
constexpr int NSLOT = 3, SLOTB = 8192;
constexpr int LDS_K = 0, LDS_V = NSLOT * SLOTB;
__device__ __forceinline__ void glds16(const void* ubase, unsigned voff, unsigned lds_dst) { unsigned keep;
  asm volatile("s_mov_b32 %0, m0\n\ts_mov_b32 m0, %3\n\ts_nop 0\n\tglobal_load_lds_dwordx4 %1, %2\n\ts_mov_b32 m0, %0" : "=&s"(keep) : "v"(voff), "s"(ubase), "s"(lds_dst) : "memory"); }
__device__ __forceinline__ float max3f(float a, float b, float c) { float r; asm("v_max3_f32 %0, %1, %2, %3" : "=v"(r) : "v"(a), "v"(b), "v"(c)); return r; }
__device__ __forceinline__ float max2f(float a, float b) { float r; asm("v_max_f32_e32 %0, %1, %2" : "=v"(r) : "v"(a), "v"(b)); return r; }
__device__ __forceinline__ float fadd_s(float a, float b) { float r; asm("v_add_f32_e32 %0, %1, %2" : "=v"(r) : "v"(a), "v"(b)); return r; }
__device__ __forceinline__ float fsub_s(float a, float b) { float r; asm("v_sub_f32_e32 %0, %1, %2" : "=v"(r) : "v"(a), "v"(b)); return r; }
typedef float f32x2_t __attribute__((ext_vector_type(2))); typedef __bf16 bf16x2_t __attribute__((ext_vector_type(2)));
__device__ __forceinline__ unsigned cvtpk_s(float lo, float hi) { f32x2_t v = {lo, hi}; bf16x2_t b = __builtin_convertvector(v, bf16x2_t); return __builtin_bit_cast(unsigned, b); }
#define WAIT_BAR(N) asm volatile("s_waitcnt vmcnt(" #N ") lgkmcnt(0)\n\ts_barrier" ::: "memory")

__device__ __forceinline__ void qkt(f32x16& p0, f32x16& p1, const char* Kslot, const bf16x8* qr, const f32x16& negm, int r32, int hi) {
  const char* kb = Kslot + hi * 1024 + r32 * 16;
  #pragma unroll
  for (int d0 = 0; d0 < 4; ++d0) {
    const bf16x8 b0 = *reinterpret_cast<const bf16x8*>(kb + d0 * 2048);
    const bf16x8 b1 = *reinterpret_cast<const bf16x8*>(kb + d0 * 2048 + 512);
    if (d0 == 0) { p0 = __builtin_amdgcn_mfma_f32_32x32x16_bf16(b0, qr[0], negm, 0, 0, 0); p1 = __builtin_amdgcn_mfma_f32_32x32x16_bf16(b1, qr[0], negm, 0, 0, 0); }
    else { p0 = __builtin_amdgcn_mfma_f32_32x32x16_bf16(b0, qr[d0], p0, 0, 0, 0); p1 = __builtin_amdgcn_mfma_f32_32x32x16_bf16(b1, qr[d0], p1, 0, 0, 0); } }
}
typedef __attribute__((address_space(3))) const char* lds_cptr;
typedef short v4i16_t __attribute__((ext_vector_type(4)));
__device__ __forceinline__ void kload8(bf16x8* kf, lds_cptr kp) {
  kf[0] = *(const __attribute__((address_space(3))) bf16x8*)(kp);        kf[1] = *(const __attribute__((address_space(3))) bf16x8*)(kp + 512);
  kf[2] = *(const __attribute__((address_space(3))) bf16x8*)(kp + 2048); kf[3] = *(const __attribute__((address_space(3))) bf16x8*)(kp + 2560);
  kf[4] = *(const __attribute__((address_space(3))) bf16x8*)(kp + 4096); kf[5] = *(const __attribute__((address_space(3))) bf16x8*)(kp + 4608);
  kf[6] = *(const __attribute__((address_space(3))) bf16x8*)(kp + 6144); kf[7] = *(const __attribute__((address_space(3))) bf16x8*)(kp + 6656);
}
__device__ __forceinline__ void kload2(bf16x8* kf, lds_cptr kp, int j) { kf[2 * j] = *(const __attribute__((address_space(3))) bf16x8*)(kp + j * 2048); kf[2 * j + 1] = *(const __attribute__((address_space(3))) bf16x8*)(kp + j * 2048 + 512); }
__device__ __forceinline__ s16x4 vtr(lds_cptr p) { return __builtin_bit_cast(s16x4, __builtin_amdgcn_ds_read_tr16_b64_v4i16((__attribute__((address_space(3))) v4i16_t*)p)); }
__device__ __forceinline__ float rowmax(const f32x16& p0, const f32x16& p1) {
  float a = max3f(p0[0], p0[1], p1[0]), b = max3f(p0[2], p0[3], p1[1]); a = max3f(a, p1[2], p1[3]);
  #pragma unroll
  for (int r = 4; r < 16; r += 4) { a = max3f(a, p0[r], p0[r + 1]); b = max3f(b, p0[r + 2], p0[r + 3]); a = max3f(a, p1[r], p1[r + 1]); b = max3f(b, p1[r + 2], p1[r + 3]); }
  const float m = max2f(a, b);
  auto rr = __builtin_amdgcn_permlane32_swap(__float_as_uint(m), __float_as_uint(m), false, false);
  return max2f(__uint_as_float(rr[0]), __uint_as_float(rr[1]));
}
__device__ __forceinline__ void pv(f32x16* o, int vb, bf16x8 pa0, bf16x8 pa1, bf16x8 pa2, bf16x8 pa3) {
  #pragma unroll
  for (int d0 = 0; d0 < 2; ++d0) { s16x4 lo[4], hi[4];
    #pragma unroll
    for (int ks = 0; ks < 4; ++ks) {
      asm volatile("ds_read_b64_tr_b16 %0,%1 offset:%c2" : "=&v"(lo[ks]) : "v"(vb), "i"(d0 * 4096 + ks * 1024) : "memory");
      asm volatile("ds_read_b64_tr_b16 %0,%1 offset:%c2" : "=&v"(hi[ks]) : "v"(vb), "i"(d0 * 4096 + ks * 1024 + 512) : "memory"); }
    asm volatile("s_waitcnt lgkmcnt(0)" ::: "memory"); SBAR();
    #define PK(k) (bf16x8){lo[k][0], lo[k][1], lo[k][2], lo[k][3], hi[k][0], hi[k][1], hi[k][2], hi[k][3]}
    o[d0] = __builtin_amdgcn_mfma_f32_32x32x16_bf16(pa0, PK(0), o[d0], 0, 0, 0);
    o[d0] = __builtin_amdgcn_mfma_f32_32x32x16_bf16(pa1, PK(1), o[d0], 0, 0, 0);
    o[d0] = __builtin_amdgcn_mfma_f32_32x32x16_bf16(pa2, PK(2), o[d0], 0, 0, 0);
    o[d0] = __builtin_amdgcn_mfma_f32_32x32x16_bf16(pa3, PK(3), o[d0], 0, 0, 0);
    #undef PK
  }
}
template <int THRL, int KP, int DV2, bool NOMAX = false> __device__ __forceinline__ void attn_unit(int q0, const bf16* Qh, const bf16* __restrict__ Kh, const bf16* __restrict__ Vh, bf16* Oh, char* shm, const int tid, const bool comb = false, const float lam = 0.f, const float* subln = nullptr) {
  constexpr int OP = 1024, NT = 64;
  constexpr int LDS_WS = LDS_V + DV2 * NSLOT * SLOTB, LDS_OST = LDS_WS + NW * 64 * 4;
  const int lane = tid & 63, r32 = lane & 31, hi = lane >> 5; const int wid = __builtin_amdgcn_readfirstlane(tid >> 6);
  const bf16* Qw = Qh + (long)(q0 + wid * QBLK) * KP;
  const unsigned lds0 = (unsigned)(uintptr_t)shm;
  float* wsf = (float*)(shm + LDS_WS) + wid * 64;
  const bf16* ksrc = Kh + wid * 8; const unsigned kvo = (unsigned)(lane * KP) * 2u;
  const bf16* vsrc = Vh + (long)(16 * (wid & 3)) * KP + (wid >> 2) * 32; const unsigned vvo = (unsigned)((lane >> 2) * KP + (lane & 3) * 8) * 2u;
  const unsigned kdst = lds0 + LDS_K + wid * 1024, vdst = lds0 + LDS_V + wid * 1024;
  #define DMA_K(t, slot) glds16(ksrc + (long)(t) * KVBLK * KP, kvo, (unsigned)__builtin_amdgcn_readfirstlane(kdst + (slot)))
  #define DMA_V(t, slot) do { glds16(vsrc + (long)(t) * KVBLK * KP, vvo, (unsigned)__builtin_amdgcn_readfirstlane(vdst + DV2 * (slot))); \
    if constexpr (DV2 == 2) glds16(vsrc + 64 + (long)(t) * KVBLK * KP, vvo, (unsigned)__builtin_amdgcn_readfirstlane(vdst + DV2 * (slot) + 8192)); } while (0)
  const int vb0 = (int)(lds0 + LDS_V) + ((lane >> 4) & 1) * 32 + (lane & 3) * 8 + (4 * hi + ((lane & 15) >> 2)) * 64;
  const char* Kbase = shm + LDS_K; bf16x8 kf[8];
  const lds_cptr shm3 = (lds_cptr)shm; const lds_cptr kp0 = shm3 + LDS_K + hi * 1024 + r32 * 16; const lds_cptr vp0 = shm3 + LDS_V + ((lane >> 4) & 1) * 32 + (lane & 3) * 8 + (4 * hi + ((lane & 15) >> 2)) * 64;
  DMA_K(0, 0); DMA_V(0, 0); DMA_K(1, SLOTB);
  bf16x8 qr[4];
  #pragma unroll
  for (int d0 = 0; d0 < 4; ++d0) qr[d0] = *reinterpret_cast<const bf16x8*>(&Qw[(long)r32 * KP + d0 * 16 + hi * 8]);
  float z0 = 0.f; asm volatile("" : "+v"(z0)); float mhat = z0, l_reg = z0; f32x16 o[2 * DV2], negm;
  _Pragma("unroll") for (int r = 0; r < 16; ++r) { _Pragma("unroll") for (int d_ = 0; d_ < 2 * DV2; ++d_) o[d_][r] = z0; negm[r] = z0; } asm volatile("" : "+v"(negm));
  bool resc = false;
  #define START(P0, P1) do { resc = false; \
    if constexpr (!NOMAX) { const float rm = rowmax(P0, P1); const float dl = rm; mhat = fadd_s(mhat, dl); \
      _Pragma("unroll") for (int r = 0; r < 16; ++r) { P0[r] = fsub_s(P0[r], dl); P1[r] = fsub_s(P1[r], dl); } \
      _Pragma("unroll") for (int r = 0; r < 16; ++r) negm[r] = -mhat; asm volatile("" : "+v"(negm)); } \
    _Pragma("unroll") for (int r = 0; r < 16; ++r) P0[r] = __builtin_amdgcn_exp2f(P0[r]); } while (0)
  #define RESC() do { if constexpr (!NOMAX) if (resc) { asm volatile("s_waitcnt lgkmcnt(0)" ::: "memory"); \
      _Pragma("unroll") for (int d_ = 0; d_ < 2 * DV2; ++d_) _Pragma("unroll") for (int r = 0; r < 16; ++r) o[d_][r] *= wsf[crow(r, hi)]; } } while (0)
  f32x16 pA0, pA1, pB0, pB1;
  int sl_prev = 0, sl_cur = 0, sl_next = SLOTB;
  #define ROT() do { sl_prev = sl_cur; sl_cur = sl_next; sl_next = (sl_next == (NSLOT - 1) * SLOTB) ? 0 : sl_next + SLOTB; } while (0)
  DMA_K(2, 2 * SLOTB);
  if constexpr (DV2 == 2) { WAIT_BAR(4); } else { WAIT_BAR(3); }
  qkt(pA0, pA1, Kbase, qr, negm, r32, hi); asm volatile("s_nop 15\n\ts_nop 7" : "+v"(pA0), "+v"(pA1));
  START(pA0, pA1);
  _Pragma("unroll") for (int r = 0; r < 16; ++r) pA1[r] = __builtin_amdgcn_exp2f(pA1[r]);
  WAIT_BAR(0);
  DMA_K(3, 0); DMA_V(1, SLOTB);
  ROT();
  kload8(kf, kp0 + sl_cur);
  if constexpr (DV2 == 2) { WAIT_BAR(3); } else { WAIT_BAR(2); }
  s16x4 vlo[8], vhi[8]; u32x4 pw0, pw1, pw2, pw3;
  #define PKW(P, B) cvtpk_s(P[B], P[B + 1])
  #define PAF(k) __builtin_bit_cast(bf16x8, pw##k)
  #define VFR(i) (bf16x8){vlo[i][0], vlo[i][1], vlo[i][2], vlo[i][3], vhi[i][0], vhi[i][1], vhi[i][2], vhi[i][3]}
  #define PIN(x) asm volatile("" : "+v"(x))
  #define MX3(a, b, c) __builtin_fmaxf(__builtin_fmaxf((a), (b)), (c))
  #define GAPA(MF, A0, A1, A2, A3, W0, W1, PW) do { MF; sacc += A0; sacc += A1; sacc += A2; sacc += A3; PIN(sacc); W0; W1; PIN(PW); SBAR(); } while (0)
  #define EX(v) __builtin_amdgcn_exp2f(v)
  #define GAPB(MF, X, B) do { MF; X[B] = EX(X[B]); X[B + 1] = EX(X[B + 1]); X[B + 2] = EX(X[B + 2]); X[B + 3] = EX(X[B + 3]); PIN(X); SBAR(); } while (0)
  #define VRD(i) do { vlo[i] = vtr(vp_ + (((i) >> 2) * 4096 + ((i) & 3) * 1024)); vhi[i] = vtr(vp_ + (((i) >> 2) * 4096 + ((i) & 3) * 1024 + 512)); } while (0)
  #define VRD2(i) do { if constexpr (DV2 == 2) { vlo[i] = vtr(vp_ + (8192 + ((i) >> 2) * 4096 + ((i) & 3) * 1024)); vhi[i] = vtr(vp_ + (8192 + ((i) >> 2) * 4096 + ((i) & 3) * 1024 + 512)); SBAR(); } } while (0)
  #define KRD(G, j) do { if (G) { kload2(kf, kp0 + sl_next, j); SBAR(); } } while (0)
  #define STEP(C0, C1, P0, P1, t, GK, GV, GL) do { SBAR(); \
    const lds_cptr vp_ = vp0 + DV2 * sl_prev; \
    VRD(0); SBAR(); float sacc = (P0[0] + P0[1]); \
    GAPA(C0 = __builtin_amdgcn_mfma_f32_32x32x16_bf16(kf[0], qr[0], negm, 0, 0, 0), P0[2], P0[3], P0[4], P0[5],     pw0[0] = PKW(P0, 0), pw0[1] = PKW(P0, 2), pw0); \
    VRD(4); SBAR(); GAPA(C1 = __builtin_amdgcn_mfma_f32_32x32x16_bf16(kf[1], qr[0], negm, 0, 0, 0), P0[6], P0[7], P0[8], P0[9],     pw0[2] = PKW(P0, 4), pw0[3] = PKW(P0, 6), pw0); \
    VRD(1); SBAR(); GAPA(C0 = __builtin_amdgcn_mfma_f32_32x32x16_bf16(kf[2], qr[1], C0, 0, 0, 0),   P0[10], P0[11], P0[12], P0[13], pw1[0] = PKW(P0, 8), pw1[1] = PKW(P0, 10), pw1); \
    VRD(5); SBAR(); GAPA(C1 = __builtin_amdgcn_mfma_f32_32x32x16_bf16(kf[3], qr[1], C1, 0, 0, 0),   P0[14], P0[15], P1[0], P1[1],   pw1[2] = PKW(P0, 12), pw1[3] = PKW(P0, 14), pw1); \
    VRD(2); SBAR(); GAPA(C0 = __builtin_amdgcn_mfma_f32_32x32x16_bf16(kf[4], qr[2], C0, 0, 0, 0),   P1[2], P1[3], P1[4], P1[5],     pw2[0] = PKW(P1, 0), pw2[1] = PKW(P1, 2), pw2); \
    VRD(6); SBAR(); GAPA(C1 = __builtin_amdgcn_mfma_f32_32x32x16_bf16(kf[5], qr[2], C1, 0, 0, 0),   P1[6], P1[7], P1[8], P1[9],     pw2[2] = PKW(P1, 4), pw2[3] = PKW(P1, 6), pw2); \
    VRD(3); SBAR(); GAPA(C0 = __builtin_amdgcn_mfma_f32_32x32x16_bf16(kf[6], qr[3], C0, 0, 0, 0),   P1[10], P1[11], P1[12], P1[13], pw3[0] = PKW(P1, 8), pw3[1] = PKW(P1, 10), pw3); \
    VRD(7); SBAR(); GAPA(C1 = __builtin_amdgcn_mfma_f32_32x32x16_bf16(kf[7], qr[3], C1, 0, 0, 0),   P1[14], P1[15], 0.f, 0.f,       pw3[2] = PKW(P1, 12), pw3[3] = PKW(P1, 14), pw3); \
    l_reg += sacc; \
    if (GK) { DMA_K((t) + 3, sl_cur); } if (GV) { DMA_V((t) + 1, sl_next); } \
    if constexpr (!NOMAX) { float a = MX3(C0[0], C0[1], C1[0]), b = MX3(C0[2], C0[3], C1[1]); a = MX3(a, C1[2], C1[3]); \
      _Pragma("unroll") for (int r = 4; r < 16; r += 4) { a = MX3(a, C0[r], C0[r + 1]); b = MX3(b, C0[r + 2], C0[r + 3]); a = MX3(a, C1[r], C1[r + 1]); b = MX3(b, C1[r + 2], C1[r + 3]); } \
      float rm = __builtin_fmaxf(a, b); { auto rr = __builtin_amdgcn_permlane32_swap(__float_as_uint(rm), __float_as_uint(rm), false, false); rm = __builtin_fmaxf(__uint_as_float(rr[0]), __uint_as_float(rr[1])); } \
      resc = false; \
      if (__builtin_expect(__any(rm > (float)THRL), 0)) { const float dl = __builtin_fmaxf(rm, 0.f); mhat += dl; \
        _Pragma("unroll") for (int r = 0; r < 16; ++r) { C0[r] -= dl; C1[r] -= dl; } \
        _Pragma("unroll") for (int r = 0; r < 16; ++r) negm[r] = -mhat; asm volatile("" : "+v"(negm)); \
        const float f = __builtin_amdgcn_exp2f(-dl); l_reg *= f; if (hi == 0) wsf[r32] = f; resc = true; } } \
    SBAR(); \
    GAPB(o[0] = __builtin_amdgcn_mfma_f32_32x32x16_bf16(PAF(0), VFR(0), o[0], 0, 0, 0), C0, 0); VRD2(0); \
    GAPB(o[1] = __builtin_amdgcn_mfma_f32_32x32x16_bf16(PAF(0), VFR(4), o[1], 0, 0, 0), C0, 4); VRD2(4); \
    KRD(GL, 0); GAPB(o[0] = __builtin_amdgcn_mfma_f32_32x32x16_bf16(PAF(1), VFR(1), o[0], 0, 0, 0), C0, 8); VRD2(1); \
    KRD(GL, 1); GAPB(o[1] = __builtin_amdgcn_mfma_f32_32x32x16_bf16(PAF(1), VFR(5), o[1], 0, 0, 0), C0, 12); VRD2(5); \
    KRD(GL, 2); GAPB(o[0] = __builtin_amdgcn_mfma_f32_32x32x16_bf16(PAF(2), VFR(2), o[0], 0, 0, 0), C1, 0); VRD2(2); \
    KRD(GL, 3); GAPB(o[1] = __builtin_amdgcn_mfma_f32_32x32x16_bf16(PAF(2), VFR(6), o[1], 0, 0, 0), C1, 4); VRD2(6); \
    GAPB(o[0] = __builtin_amdgcn_mfma_f32_32x32x16_bf16(PAF(3), VFR(3), o[0], 0, 0, 0), C1, 8); VRD2(3); \
    GAPB(o[1] = __builtin_amdgcn_mfma_f32_32x32x16_bf16(PAF(3), VFR(7), o[1], 0, 0, 0), C1, 12); VRD2(7); \
    if constexpr (DV2 == 2) { \
      o[2] = __builtin_amdgcn_mfma_f32_32x32x16_bf16(PAF(0), VFR(0), o[2], 0, 0, 0); o[3] = __builtin_amdgcn_mfma_f32_32x32x16_bf16(PAF(0), VFR(4), o[3], 0, 0, 0); \
      o[2] = __builtin_amdgcn_mfma_f32_32x32x16_bf16(PAF(1), VFR(1), o[2], 0, 0, 0); o[3] = __builtin_amdgcn_mfma_f32_32x32x16_bf16(PAF(1), VFR(5), o[3], 0, 0, 0); \
      o[2] = __builtin_amdgcn_mfma_f32_32x32x16_bf16(PAF(2), VFR(2), o[2], 0, 0, 0); o[3] = __builtin_amdgcn_mfma_f32_32x32x16_bf16(PAF(2), VFR(6), o[3], 0, 0, 0); \
      o[2] = __builtin_amdgcn_mfma_f32_32x32x16_bf16(PAF(3), VFR(3), o[2], 0, 0, 0); o[3] = __builtin_amdgcn_mfma_f32_32x32x16_bf16(PAF(3), VFR(7), o[3], 0, 0, 0); SBAR(); } \
    } while (0)
  int t = 1;
  for (; t + 5 < NT; t += 2) {
    STEP(pB0, pB1, pA0, pA1, t, true, true, true);     if constexpr (DV2 == 2) { WAIT_BAR(3); } else { WAIT_BAR(2); } RESC(); ROT();
    STEP(pA0, pA1, pB0, pB1, t + 1, true, true, true); if constexpr (DV2 == 2) { WAIT_BAR(3); } else { WAIT_BAR(2); } RESC(); ROT();
  }
  #define ENDW(tt) do { if constexpr (DV2 == 2) { if ((tt) + 3 < NT) { WAIT_BAR(3); } else if ((tt) + 2 < NT) { WAIT_BAR(2); } else { WAIT_BAR(0); } } \
    else { if ((tt) + 3 < NT) { WAIT_BAR(2); } else if ((tt) + 2 < NT) { WAIT_BAR(1); } else { WAIT_BAR(0); } } } while (0)
  for (; t + 1 < NT; t += 2) {
    STEP(pB0, pB1, pA0, pA1, t, (t + 3 < NT), (t + 1 < NT), (t + 1 < NT));         ENDW(t);     RESC(); ROT();
    STEP(pA0, pA1, pB0, pB1, t + 1, (t + 4 < NT), (t + 2 < NT), (t + 2 < NT));     ENDW(t + 1); RESC(); ROT();
  }
  STEP(pB0, pB1, pA0, pA1, NT - 1, false, false, false); RESC();
  { float sacc = pB0[0] + pB0[1]; _Pragma("unroll") for (int r = 2; r < 16; ++r) sacc += pB0[r]; _Pragma("unroll") for (int r = 0; r < 16; ++r) sacc += pB1[r]; l_reg += sacc;
    pw0 = (u32x4){PKW(pB0, 0), PKW(pB0, 2), PKW(pB0, 4), PKW(pB0, 6)}; pw1 = (u32x4){PKW(pB0, 8), PKW(pB0, 10), PKW(pB0, 12), PKW(pB0, 14)}; pw2 = (u32x4){PKW(pB1, 0), PKW(pB1, 2), PKW(pB1, 4), PKW(pB1, 6)}; pw3 = (u32x4){PKW(pB1, 8), PKW(pB1, 10), PKW(pB1, 12), PKW(pB1, 14)};
    SBAR(); pv(o, vb0 + DV2 * sl_cur, PAF(0), PAF(1), PAF(2), PAF(3)); if constexpr (DV2 == 2) pv(o + 2, vb0 + DV2 * sl_cur + 8192, PAF(0), PAF(1), PAF(2), PAF(3)); }
  #undef PKW
  #undef PAF
  #undef VFR
  #undef PIN
  #undef MX3
  #undef GAPA
  #undef GAPB
  #undef EX
  #undef VRD
  #undef KRD
  #undef VRD2
  #undef STEP
  #undef ENDW
  { auto rr = __builtin_amdgcn_permlane32_swap(__float_as_uint(l_reg), __float_as_uint(l_reg), false, false); l_reg = __uint_as_float(rr[0]) + __uint_as_float(rr[1]); }
  int lane_e; asm volatile("v_mbcnt_lo_u32_b32 %0, -1, 0\n\tv_mbcnt_hi_u32_b32 %0, -1, %0" : "=v"(lane_e));
  const int r32e = lane_e & 31, hie = lane_e >> 5;
  if (hie == 0) wsf[32 + r32e] = l_reg; asm volatile("s_waitcnt lgkmcnt(0)" ::: "memory");
  float rli[16];
  #pragma unroll
  for (int r = 0; r < 16; ++r) rli[r] = __builtin_amdgcn_rcpf(wsf[32 + crow(r, hie)]);
  bf16* Ow = Oh + (long)(q0 + wid * QBLK) * OP;
  { bf16* stg = (bf16*)(shm + LDS_OST) + wid * 2048;
    if (DV2 == 2 && comb) {
      asm volatile("s_waitcnt vmcnt(0)" ::: "memory");
      u32x4 w1a[2][4];
      #pragma unroll
      for (int hv = 0; hv < DV2; ++hv)
        #pragma unroll
        for (int i = 0; i < 4; ++i) { const int row = i * 8 + (lane_e >> 3), ch = lane_e & 7; w1a[hv][i] = *(const u32x4*)(Ow + (long)row * OP + hv * 64 + ch * 8); }
      float dd[2][4][8]; float ss[4] = {0.f, 0.f, 0.f, 0.f};
      #pragma unroll
      for (int hv = 0; hv < DV2; ++hv) {
        #pragma unroll
        for (int r = 0; r < 16; ++r) { const int orow = crow(r, hie);
          #pragma unroll
          for (int d0 = 0; d0 < 2; ++d0) stg[orow * 64 + d0 * 32 + r32e] = __float2bfloat16(o[2 * hv + d0][r] * rli[r]); }
        asm volatile("s_waitcnt lgkmcnt(0)" ::: "memory");
        #pragma unroll
        for (int i = 0; i < 4; ++i) { const int row = i * 8 + (lane_e >> 3), ch = lane_e & 7; const u32x4 v = *(const u32x4*)(stg + row * 64 + ch * 8);
          const u32x4 w1 = w1a[hv][i];
          #pragma unroll
          for (int j = 0; j < 4; ++j) { const float a0 = __uint_as_float(w1[j] << 16), a1 = __uint_as_float(w1[j] & 0xffff0000u), b0 = __uint_as_float(v[j] << 16), b1 = __uint_as_float(v[j] & 0xffff0000u);
            const float e0 = a0 - lam * b0, e1 = a1 - lam * b1; dd[hv][i][2 * j] = e0; dd[hv][i][2 * j + 1] = e1; ss[i] += e0 * e0 + e1 * e1; } }
        asm volatile("s_waitcnt lgkmcnt(0)" ::: "memory"); }
      #pragma unroll
      for (int i = 0; i < 4; ++i) {
        float t = ss[i];
        #pragma unroll
        for (int m_ = 1; m_ < 8; m_ <<= 1) t += __builtin_bit_cast(float, __builtin_amdgcn_ds_bpermute((lane_e ^ m_) << 2, __builtin_bit_cast(int, t)));
        const float rinv = (1.0f - 0.47071301834358366f) / sqrtf(t * (1.0f / 128.0f) + 1e-6f);
        const int row = i * 8 + (lane_e >> 3), ch = lane_e & 7;
        #pragma unroll
        for (int hv = 0; hv < DV2; ++hv) { const float* gp = subln + hv * 64 + ch * 8; u32x4 w;
          #pragma unroll
          for (int j = 0; j < 4; ++j) w[j] = cvtpk_s(dd[hv][i][2 * j] * rinv * gp[2 * j], dd[hv][i][2 * j + 1] * rinv * gp[2 * j + 1]);
          *(u32x4*)(Ow + (long)row * OP + hv * 64 + ch * 8) = w; } }
    } else {
    #pragma unroll
    for (int hv = 0; hv < DV2; ++hv) {
    #pragma unroll
    for (int r = 0; r < 16; ++r) { const int orow = crow(r, hie);
      #pragma unroll
      for (int d0 = 0; d0 < 2; ++d0) stg[orow * 64 + d0 * 32 + r32e] = __float2bfloat16(o[2 * hv + d0][r] * rli[r]); }
    asm volatile("s_waitcnt lgkmcnt(0)" ::: "memory");
    #pragma unroll
    for (int i = 0; i < 4; ++i) { const int row = i * 8 + (lane_e >> 3), ch = lane_e & 7; const u32x4 v = *(const u32x4*)(stg + row * 64 + ch * 8); *(u32x4*)(Ow + (long)row * OP + hv * 64 + ch * 8) = v; }
    asm volatile("s_waitcnt lgkmcnt(0)" ::: "memory"); } } }
  asm volatile("s_waitcnt lgkmcnt(0)\n\ts_barrier" ::: "memory");
  #undef DMA_K
  #undef DMA_V
  #undef START
  #undef RESC
  #undef ROT
}
#undef SBAR
#undef WAIT_BAR
}

#define LDS_WAIT() asm volatile("s_waitcnt lgkmcnt(0)" ::: "memory")
__device__ __forceinline__ unsigned f2bf(float f) { unsigned u = __builtin_bit_cast(unsigned, f); return (u + 0x7fffu + ((u >> 16) & 1u)) >> 16; }
__device__ __forceinline__ unsigned pk2(float lo, float hi) { return f2bf(lo) | (f2bf(hi) << 16); }
__device__ __forceinline__ f32x4 ldh4(const bf16_t* p) { const u32x2 w = *(const u32x2*)p; return (f32x4){(float)__builtin_bit_cast(_Float16, (unsigned short)(w.x & 0xffffu)), (float)__builtin_bit_cast(_Float16, (unsigned short)(w.x >> 16)), (float)__builtin_bit_cast(_Float16, (unsigned short)(w.y & 0xffffu)), (float)__builtin_bit_cast(_Float16, (unsigned short)(w.y >> 16))}; }
__device__ __forceinline__ float bf2f(unsigned short b) { return __builtin_bit_cast(float, (unsigned)b << 16); }
__device__ __forceinline__ float wave_sum(float v, int lane) {
#pragma unroll
    for (int o = 1; o < 64; o <<= 1) v += shx(v, lane, o);
    return v;
}
__device__ __forceinline__ int wpos(int mode, int L) {
    if (mode == 1) { const int d = L & 63, fq = 2 * (d >> 5) + ((d >> 3) & 1); return (L & ~255) + ((d >> 4) & 1) * 128 + ((L >> 6) & 3) * 32 + 8 * fq + (d & 7); }
    if (mode == 2) { const int bj = L >= DFF ? 1 : 0, rem = L - bj * DFF; return (rem >> 7) * 256 + bj * 128 + (rem & 127); }
    return L;
}
__device__ __forceinline__ void transpose_item(const float* W, int K, int N, bf16_t* WT, int mode, LAS float* scr, int item, int lane) {
    const int nblk = N / 32, kb = item / nblk, nb = item % nblk, k0 = 64 * kb, n0 = 32 * nb;
    {
        const int rr = lane >> 3, c4 = (lane & 7) * 4;
        f32x4 v[8];
#pragma unroll
        for (int i = 0; i < 8; ++i) v[i] = *(const f32x4*)(W + (size_t)(k0 + 8 * i + rr) * N + n0 + c4);
#pragma unroll
        for (int i = 0; i < 8; ++i) { LAS float* d = scr + (8 * i + rr) * 33 + c4; d[0] = v[i].x; d[1] = v[i].y; d[2] = v[i].z; d[3] = v[i].w; }
    }
    LDS_WAIT(); asm volatile("" ::: "memory");
    const int c = lane & 7;
#pragma unroll
    for (int j = 0; j < 4; ++j) { const int n = (lane >> 3) + 8 * j; const LAS float* s = scr + (8 * c) * 33 + n;
        u32x4 o; o.x = pk2(s[0 * 33], s[1 * 33]); o.y = pk2(s[2 * 33], s[3 * 33]); o.z = pk2(s[4 * 33], s[5 * 33]); o.w = pk2(s[6 * 33], s[7 * 33]);
        *(u32x4*)(WT + (size_t)wpos(mode, n0 + n) * K + k0 + 8 * c) = o; }
    LDS_WAIT(); asm volatile("" ::: "memory");
}


#define XB_TMO      128
#define XB_XCNT(j)  (256  + 64 * (j))
#define XB_XSUB(j)  (1280 + 64 * (j))
#define XB_XGEN(j)  (2304 + 64 * (j))
#define XB_TOP      3328
#define XB_TOPGEN   3392
#define XCD_BAR_WORDS 3456
#define XB_SPIN_CAP (1u << 22)
__device__ __forceinline__ unsigned xb_ld(unsigned* p)              { return __hip_atomic_load(p, __ATOMIC_RELAXED, __HIP_MEMORY_SCOPE_AGENT); }
__device__ __forceinline__ unsigned xb_add(unsigned* p, unsigned v) { return __hip_atomic_fetch_add(p, v, __ATOMIC_RELAXED, __HIP_MEMORY_SCOPE_AGENT); }
__device__ __forceinline__ unsigned xb_xcc_id() { return (unsigned)__builtin_amdgcn_s_getreg((3 << 11) | 20) & 0xFu; }
#define XB_SPIN(cond, bar) do { unsigned _sp = 0; while (cond) { __builtin_amdgcn_s_sleep(1); \
    if ((++_sp & 255u) == 0u) { if (xb_ld(&(bar)[XB_TMO])) break; if (_sp > XB_SPIN_CAP) { atomicAdd(&(bar)[XB_TMO], 1u); break; } } } } while (0)
struct XcdBarrier { unsigned* bar; unsigned x; volatile LAS unsigned* st; };
__device__ __forceinline__ void xcd_barrier_complete(unsigned* bar, unsigned x, unsigned& nloc, unsigned& nx) {
    const unsigned G = gridDim.x * gridDim.y * gridDim.z;
    unsigned sum, cnt, mine, sp = 0u;
    for (;;) {
        sum = 0u; cnt = 0u; mine = 0u;
#pragma unroll
        for (unsigned j = 0; j < 16; ++j) { const unsigned c = xb_ld(&bar[XB_XCNT(j)]); sum += c; cnt += (c > 0u) ? 1u : 0u; mine = (j == x) ? c : mine; }
        if (sum == G) break;
        __builtin_amdgcn_s_sleep(1);
        if ((++sp & 255u) == 0u) { if (xb_ld(&bar[XB_TMO])) break; if (sp > XB_SPIN_CAP) { atomicAdd(&bar[XB_TMO], 1u); break; } }
    }
    nloc = mine > 0u ? mine : 1u; nx = cnt > 0u ? cnt : 1u;
}
__device__ __forceinline__ void xcd_barrier(const XcdBarrier& b) {
    asm volatile("s_waitcnt vmcnt(0)" ::: "memory");
    __syncthreads();
    if (threadIdx.x == 0) {
        unsigned* bar = b.bar;
        __builtin_amdgcn_s_waitcnt(0);
        unsigned nloc = b.st[0], nx = b.st[1];
        if (nloc == 0u) { xcd_barrier_complete(bar, b.x, nloc, nx); b.st[0] = nloc; b.st[1] = nx; }
        const unsigned old = xb_add(&bar[XB_XSUB(b.x)], 1u);
        const unsigned gen = old / nloc;
        if (old + 1u == (gen + 1u) * nloc) {
            __builtin_amdgcn_fence(__ATOMIC_RELEASE, "agent");
            asm volatile("s_waitcnt vmcnt(0)" ::: "memory");
            const unsigned og = xb_add(&bar[XB_TOP], 1u);
            const unsigned tg = og / nx;
            if (og + 1u == (tg + 1u) * nx) xb_add(&bar[XB_TOPGEN], 1u);
            else XB_SPIN(xb_ld(&bar[XB_TOPGEN]) == tg, bar);
            __builtin_amdgcn_fence(__ATOMIC_ACQUIRE, "agent");
            xb_add(&bar[XB_XGEN(b.x)], 1u);
            asm volatile("s_waitcnt vmcnt(0)" ::: "memory");
        } else {
            XB_SPIN(xb_ld(&bar[XB_XGEN(b.x)]) == gen, bar);
            __builtin_amdgcn_fence(__ATOMIC_ACQUIRE, "agent");
            asm volatile("s_waitcnt vmcnt(0)" ::: "memory");
        }
    }
    __syncthreads();
}

struct Args { const float* in[50]; float* out; unsigned char* ws; };

__global__ void __launch_bounds__(512, 2) mk_fwd(Args a) {
    extern __shared__ __attribute__((aligned(16))) unsigned char lds[];
    cg::grid_group grid = cg::this_grid();
    LAS unsigned char* ldsl = (LAS unsigned char*)lds;
    const int G = gridDim.x, bid = blockIdx.x;
    const int wave0 = __builtin_amdgcn_readfirstlane((int)threadIdx.x >> 6);
    if (bid == 0) { for (int i = threadIdx.x; i < XCD_BAR_WORDS; i += 512) __hip_atomic_store((unsigned*)a.ws + i, 0u, __ATOMIC_RELAXED, __HIP_MEMORY_SCOPE_AGENT); }
    for (int i = bid * 512 + threadIdx.x; i < 8 * 128 * 64; i += G * 512) __hip_atomic_store((unsigned*)a.ws + 16384 + i, 0u, __ATOMIC_RELAXED, __HIP_MEMORY_SCOPE_AGENT);
    if (threadIdx.x < 64) ((volatile LAS unsigned*)(ldsl + 131072 + 512))[threadIdx.x] = 0u;
    __syncthreads();
    const int vcu = (G % 8 == 0) ? (bid % 8) * (G / 8) + bid / 8 : bid;
    const int NGW = G * 8;
#define PHASE_VARS int lane; asm volatile("v_mbcnt_lo_u32_b32 %0, -1, 0\n\tv_mbcnt_hi_u32_b32 %0, -1, %0" : "=v"(lane)); const int wave = wave0, tid = wave0 * 64 + lane, gw = vcu * 8 + wave; unsigned char* ws = a.ws; asm volatile("" : "+s"(ws)); (void)lane; (void)gw;
    { PHASE_VARS
    bf16_t* XB = (bf16_t*)(ws + WS_XB);
    float* axc = (float*)(ws + WS_AXC); float* axs = (float*)(ws + WS_AXS); float* rcT = (float*)(ws + WS_RC); float* rsT = (float*)(ws + WS_RS);

    {
        LAS float* scr = (LAS float*)(ldsl + wave * 16384);
        constexpr int I_UP = (DM / 64) * (NUP / 32), I_DN = (DFF / 64) * (DM / 32), I_Q0 = (DM / 64) * (1536 / 32), I_SQ = (DM / 64) * (DM / 32), I_Q2 = (DM / 64) * (3072 / 32);
        constexpr int NITEMS = 4 * I_UP + 4 * I_DN + 2 * I_Q0 + 4 * I_SQ + I_Q2;
#define TR(SRC, KK, NN, DSTOFF, MODE, NI) { if (r < (NI)) { transpose_item(a.in[SRC], KK, NN, (bf16_t*)(ws + (DSTOFF)), MODE, scr, r, lane); continue; } r -= (NI); }
        for (int it = gw; it < NITEMS; it += NGW) {
            int r = it;
            TR(7, DM, NUP, WS_WUP, 2, I_UP) TR(17, DM, NUP, WS_WUP + 11 * MiB, 2, I_UP) TR(32, DM, NUP, WS_WUP + 22 * MiB, 2, I_UP) TR(44, DM, NUP, WS_WUP + 33 * MiB, 2, I_UP)
            TR(10, DFF, DM, WS_WDN, 0, I_DN) TR(20, DFF, DM, WS_WDN + 5767168, 0, I_DN) TR(35, DFF, DM, WS_WDN + 2 * 5767168, 0, I_DN) TR(47, DFF, DM, WS_WDN + 3 * 5767168, 0, I_DN)
            TR(1, DM, 1536, WS_QKV0, 1, I_Q0) TR(38, DM, 1536, WS_QKV3, 1, I_Q0)
            TR(4, DM, DM, WS_WO0, 0, I_SQ) TR(13, DM, DM, WS_FWO, 0, I_SQ) TR(29, DM, DM, WS_WO2, 0, I_SQ) TR(41, DM, DM, WS_WO3, 0, I_SQ)
            TR(23, DM, 3072, WS_QKV2, 0, I_Q2)
        }
#undef TR
        for (int m = gw; m < MROWS; m += NGW) {
            const f32x4* xr = (const f32x4*)(a.in[0] + (size_t)m * DM); u32x4* o16 = (u32x4*)(XB + (size_t)m * DM);
            f32x4 va[2], vb[2];
#pragma unroll
            for (int j = 0; j < 2; ++j) { va[j] = xr[128 * j + 2 * lane]; vb[j] = xr[128 * j + 2 * lane + 1]; }
#pragma unroll
            for (int j = 0; j < 2; ++j) o16[64 * j + lane] = (u32x4){pk2(va[j].x, va[j].y), pk2(va[j].z, va[j].w), pk2(vb[j].x, vb[j].y), pk2(vb[j].z, vb[j].w)};
        }
        const int gt = vcu * 512 + tid, GT = G * 512;
        for (int i = gt; i < 512 * 256; i += GT) { const int n = i >> 8, c = i & 255, part = n >> 8, m = n & 255; const float ph = (float)((m * c) & 255) * (1.0f / 256.0f);
            const float v = part ? -__builtin_amdgcn_sinf(ph) : __builtin_amdgcn_cosf(ph); ((bf16_t*)(ws + WS_TT))[i] = (bf16_t)f2bf(v); }
        { bf16_t* A2 = (bf16_t*)(ws + WS_A2);
          for (int i = gt; i < 2048 * 4096 / 2; i += GT) { const int e = i * 2, k = e >> 12, c = e & 4095, part = c >> 11, s = c & 2047;
              const float p0 = (float)((k * s) & 4095) * (1.0f / 4096.0f), p1 = (float)((k * (s + 1)) & 4095) * (1.0f / 4096.0f);
              const float v0 = part ? __builtin_amdgcn_sinf(p0) : __builtin_amdgcn_cosf(p0), v1 = part ? __builtin_amdgcn_sinf(p1) : __builtin_amdgcn_cosf(p1);
              ((unsigned*)A2)[i] = pk2(v0, v1); } }
        for (int i = gt; i < 64 * 16; i += GT) { const int t = i >> 4, f = i & 15; const float inv = powf(10000.0f, -(float)(2 * f) / 32.0f); const float ang = (float)t * inv; axc[i] = cosf(ang); axs[i] = sinf(ang); }
        for (int i = gt; i < 4096 * 8; i += GT) { const int t = i >> 3, f = i & 7; const float inv = powf(500000.0f, -(float)(2 * f) / 16.0f); const float ang = (float)t * inv; rcT[i] = cosf(ang); rsT[i] = sinf(ang); }
    }
    }
    grid.sync();
    XcdBarrier xbar; xbar.bar = (unsigned*)a.ws; xbar.x = xb_xcc_id(); xbar.st = (volatile LAS unsigned*)(ldsl + 131072 + 512);
    if (threadIdx.x == 0) (void)xb_add(&xbar.bar[XB_XCNT(xbar.x)], 1u);
#define GSYNC() xcd_barrier(xbar)
    float* OUT = a.out;

    for (int l = 0; l < 4; ++l) {
        const int kind = (l == 3) ? 0 : l;
        for (int h = 0; h < 2; ++h) {
            const char* rA; size_t rBoff; int rK; const float* rbias = nullptr; const float* lng; const float* lnb;
            if (h == 0) {
                if (kind == 0) {
                    { PHASE_VARS
                      pg8::StaticOrder S; S.init(MROWS / 256, 1536 / 256, G, bid);
                      pg8::MapStd MP{(const char*)(ws + WS_XB), (const char*)(ws + (l == 0 ? WS_QKV0 : WS_QKV3)), (size_t)DM * 2, (size_t)DM * 2};
                      pg8::EpiQkvGqa E{(GAS bf16_t*)(ws + WS_QKV), (const GAS float*)(l == 0 ? a.in[2] : a.in[39]), (const GAS float*)(l == 0 ? a.in[3] : a.in[40]), (const GAS float*)(ws + WS_AXC), (const GAS float*)(ws + WS_AXS)};
                      pg8::gemm_phase<pg8::EpiQkvGqa, pg8::MapStd, true>(tid, ldsl, DM, DM, DM, MP, S, E); }
                    GSYNC();
                    { PHASE_VARS
                      const attn_body::bf16* QKV = (const attn_body::bf16*)(ws + WS_QKV); attn_body::bf16* O = (attn_body::bf16*)(ws + WS_O_GQA);
                      float gq = fabsf((l == 0 ? a.in[2] : a.in[39])[lane]), gk = fabsf((l == 0 ? a.in[3] : a.in[40])[lane]);
#pragma unroll
                      for (int o = 1; o < 64; o <<= 1) { gq = fmaxf(gq, shx(gq, lane, o)); gk = fmaxf(gk, shx(gk, lane, o)); }
                      const bool bounded = __builtin_amdgcn_readfirstlane((int)(11.8f * gq * gk < 90.0f)) != 0;
                      if (bounded) {
                        for (int U = vcu; U < 2048; U += G) {
                          const int grp = U >> 6, rest = U & 63, g = rest >> 4, qb = rest & 15, b = grp >> 2, kvh = grp & 3, hq = kvh * 4 + g;
                          const attn_body::bf16* base = QKV + (size_t)b * SEQ * 1536;
                          attn_body::attn_unit<8, 1536, 1, true>(qb * 256, base + hq * 64, base + 1024 + kvh * 64, base + 1280 + kvh * 64, O + (size_t)b * SEQ * DM + hq * 64, (char*)lds, tid);
                        }
                      } else {
                        for (int U = vcu; U < 2048; U += G) {
                          const int grp = U >> 6, rest = U & 63, g = rest >> 4, qb = rest & 15, b = grp >> 2, kvh = grp & 3, hq = kvh * 4 + g;
                          const attn_body::bf16* base = QKV + (size_t)b * SEQ * 1536;
                          attn_body::attn_unit<8, 1536, 1, false>(qb * 256, base + hq * 64, base + 1024 + kvh * 64, base + 1280 + kvh * 64, O + (size_t)b * SEQ * DM + hq * 64, (char*)lds, tid);
                        }
                      } }
                    GSYNC();
                    rA = (const char*)(a.ws + WS_O_GQA); rBoff = (l == 0 ? WS_WO0 : WS_WO3); rK = DM;
                } else if (kind == 1) {
                    { PHASE_VARS
                      const bf16_t* XB = (const bf16_t*)(ws + WS_XB); bf16_t* XE = (bf16_t*)(ws + WS_XE); bf16_t* XO = XE + (size_t)NB * 2048 * DM;
                      for (int r = gw; r < NB * 2048; r += NGW) {
                          const int b = r >> 11, sidx = r & 2047;
                          const u32x2* p = (const u32x2*)(XB + ((size_t)b * SEQ + sidx) * DM) + lane; const u32x2* q = (const u32x2*)(XB + ((size_t)b * SEQ + ((SEQ - sidx) & (SEQ - 1))) * DM) + lane;
                          u32x2* pe = (u32x2*)(XE + (size_t)r * DM) + lane; u32x2* po = (u32x2*)(XO + (size_t)r * DM) + lane;
#pragma unroll
                          for (int j = 0; j < 4; ++j) { const u32x2 x1 = p[64 * j], x2 = q[64 * j];
                              const float a0 = bf2f(x1.x & 0xffff), a1 = bf2f(x1.x >> 16), a2 = bf2f(x1.y & 0xffff), a3 = bf2f(x1.y >> 16);
                              const float b0 = bf2f(x2.x & 0xffff), b1 = bf2f(x2.x >> 16), b2 = bf2f(x2.y & 0xffff), b3 = bf2f(x2.y >> 16);
                              u32x2 e, o;
                              if (sidx == 0) { e = x1; o.x = 0u; o.y = 0u; }
                              else { e.x = pk2(a0 + b0, a1 + b1); e.y = pk2(a2 + b2, a3 + b3); o.x = pk2(a0 - b0, a1 - b1); o.y = pk2(a2 - b2, a3 - b3); }
                              pe[64 * j] = e; po[64 * j] = o; }
                      }
                      const int gt = vcu * 512 + tid;
                      if (gt < NB * DM) { const int b = gt >> 10, ch = gt & 1023, g = ch >> 8, m = ch & 255; const bf16_t* xr = XB + ((size_t)b * SEQ + 2048) * DM + g * 256; float acc_ = 0.f;
                          for (int c = 0; c < 256; ++c) acc_ += bf2f(xr[c]) * __builtin_amdgcn_cosf((float)((m * c) & 255) * (1.0f / 256.0f));
                          ((float*)(ws + WS_YCH))[gt] = acc_; }
                    }
                    GSYNC();
                    { PHASE_VARS
                      pg8::StaticOrder S; S.init(8, 64, G, bid);
                      pg8::MapF1 MP{(const char*)(ws + WS_TT), (const char*)(ws + WS_XE)};
                      pg8::EpiBf16<1> E{(GAS bf16_t*)(ws + WS_YT), 1.0f, (const GAS float*)nullptr};
                      pg8::gemm_phase<pg8::EpiBf16<1>, pg8::MapF1, true>(tid, ldsl, 256, DM, 256, MP, S, E); }
                    GSYNC();
                    { PHASE_VARS
                      { const bf16_t* YT = (const bf16_t*)(ws + WS_YT); const float* ych = (const float*)(ws + WS_YCH); bf16_t* Zb = (bf16_t*)OUT;
                        for (int r = gw; r < NB * DM; r += NGW) { const u32x4* p = (const u32x4*)(YT + (size_t)r * 4096) + lane; float sacc = 0.f;
#pragma unroll
                            for (int j = 0; j < 4; ++j) { const u32x4 w = p[64 * j];
#pragma unroll
                                for (int t = 0; t < 4; ++t) sacc += bf2f((unsigned short)(w[t] & 0xffffu)) - bf2f((unsigned short)(w[t] >> 16)); }
                            sacc = wave_sum(sacc, lane);
                            if (lane == 0) Zb[((size_t)(r >> 10) * SEQ + 2048) * DM + (r & 1023)] = (bf16_t)f2bf((sacc + ych[r]) * (1.0f / 1024.0f)); } }
                      pg8::StaticOrder S; S.init(128, 4, G, bid);
                      pg8::MapF2 MP{(const char*)(ws + WS_A2), (const char*)(ws + WS_YT)};
                      pg8::EpiF2s E{(GAS bf16_t*)OUT, 1.0f / 1024.0f, (const GAS float*)(ws + WS_YCH), (GAS float*)(ws + WS_R + 128 * MiB)};
                      pg8::gemm_phase<pg8::EpiF2s, pg8::MapF2, true>(tid, ldsl, 4096, 4096, 2048, MP, S, E); }
                    GSYNC();
                    rA = (const char*)OUT; rBoff = WS_FWO; rK = DM; rbias = a.in[14];
                } else {
                    { PHASE_VARS
                      pg8::StaticOrder S; S.init(MROWS / 256, 3072 / 256, G, bid);
                      pg8::MapStd MP{(const char*)(ws + WS_XB), (const char*)(ws + WS_QKV2), (size_t)DM * 2, (size_t)DM * 2};
                      pg8::EpiQkvDiff E{(GAS bf16_t*)(ws + WS_QKV), (const GAS float*)(ws + WS_RC), (const GAS float*)(ws + WS_RS)};
                      pg8::gemm_phase<pg8::EpiQkvDiff, pg8::MapStd, true>(tid, ldsl, DM, DM, DM, MP, S, E); }
                    GSYNC();
                    { PHASE_VARS
                      const attn_body::bf16* QKV = (const attn_body::bf16*)(ws + WS_QKV); attn_body::bf16* O1 = (attn_body::bf16*)(ws + WS_O12);
                      float d1 = a.in[24][lane] * a.in[25][lane], d2 = a.in[26][lane] * a.in[27][lane];
                      d1 = wave_sum(d1, lane); d2 = wave_sum(d2, lane);
                      const float lam = expf(d1) - expf(d2) + LAMBDA_INIT2;
                      for (int i = 0; i < 8; ++i) {
                          const int V = (i >> 1) * G + vcu; if (V >= 1024) break;
                          const int c = i & 1, grp = V >> 4, qb = V & 15, b = grp >> 3, hh = grp & 7;
                          const attn_body::bf16* base = QKV + (size_t)b * SEQ * 3072;
                          attn_body::attn_unit<8, 3072, 2>(qb * 256, base + (2 * hh + c) * 64, base + 1024 + (2 * hh + c) * 64, base + 2048 + hh * 128,
                                                  O1 + (size_t)b * SEQ * DM + hh * 128, (char*)lds, tid, c == 1, lam, a.in[28]);
                      } }
                    GSYNC();
                    rA = (const char*)(a.ws + WS_O12); rBoff = WS_WO2; rK = DM;
                }
                lng = a.in[l == 0 ? 5 : l == 1 ? 15 : l == 2 ? 30 : 42]; lnb = a.in[l == 0 ? 6 : l == 1 ? 16 : l == 2 ? 31 : 43];
            } else {
                const float* cw = a.in[l == 0 ? 8 : l == 1 ? 18 : l == 2 ? 33 : 45]; const float* cb = a.in[l == 0 ? 9 : l == 1 ? 19 : l == 2 ? 34 : 46];
                { PHASE_VARS
                  pg8::StaticOrder S; S.init(MROWS / 256, NUP / 256, G, bid);
                  pg8::MapStd MP{(const char*)(ws + WS_XB), (const char*)(ws + WS_WUP + (size_t)l * 11 * MiB), (size_t)DM * 2, (size_t)DM * 2};
                  pg8::EpiUpConv E{(GAS bf16_t*)(ws + WS_G), (GAS bf16_t*)(ws + WS_E), (const GAS float*)cw, (const GAS float*)cb};
                  pg8::gemm_phase<pg8::EpiUpConv, pg8::MapStd, true>(tid, ldsl, DM, DM, DM, MP, S, E); }
                GSYNC();
                { PHASE_VARS
                  bf16_t* Gb = (bf16_t*)(ws + WS_G); const bf16_t* Eb = (const bf16_t*)(ws + WS_E);
                  for (int it = gw; it < (MROWS / 32) * 6; it += NGW) {
                    const int ri = it / 6, ch = it - ri * 6;
                    const int blk = ri >> 1, side = ri & 1, row = blk * 64 + (side ? 63 : 0), s = row & (SEQ - 1);
                    const bf16_t* eu; const bf16_t* em; const bf16_t* ed; bool hasu = true, hasd = true;
                    if (side == 0) { hasu = (s != 0); eu = Eb + ((size_t)(blk - (hasu ? 1 : 0)) * 4 + 3) * NUP; em = Eb + ((size_t)blk * 4 + 0) * NUP; ed = Eb + ((size_t)blk * 4 + 1) * NUP; }
                    else { hasd = (s != SEQ - 1); eu = Eb + ((size_t)blk * 4 + 2) * NUP; em = Eb + ((size_t)blk * 4 + 3) * NUP; ed = Eb + ((size_t)(blk + (hasd ? 1 : 0)) * 4 + 0) * NUP; }
                    const float fu = hasu ? 1.f : 0.f, fd = hasd ? 1.f : 0.f;
                    const int c = ch * 512 + 8 * lane;
                    if (c < DFF) {
                        f32x4 hgv[2][2];
#pragma unroll
                        for (int p = 0; p < 2; ++p)
#pragma unroll
                            for (int q4 = 0; q4 < 2; ++q4) { const int cc = c + p * DFF + 4 * q4;
                                const f32x4 u4 = ldh4(eu + cc) * fu, m4 = ldh4(em + cc), d4 = ldh4(ed + cc) * fd;
                                hgv[p][q4] = *(const f32x4*)(cb + cc) + *(const f32x4*)(cw + cc) * u4 + *(const f32x4*)(cw + NUP + cc) * m4 + *(const f32x4*)(cw + 2 * NUP + cc) * d4; }
                        u32x4 w;
                        w.x = pk2(pg8::silu_mul(hgv[0][0][0], hgv[1][0][0]), pg8::silu_mul(hgv[0][0][1], hgv[1][0][1])); w.y = pk2(pg8::silu_mul(hgv[0][0][2], hgv[1][0][2]), pg8::silu_mul(hgv[0][0][3], hgv[1][0][3]));
                        w.z = pk2(pg8::silu_mul(hgv[0][1][0], hgv[1][1][0]), pg8::silu_mul(hgv[0][1][1], hgv[1][1][1])); w.w = pk2(pg8::silu_mul(hgv[0][1][2], hgv[1][1][2]), pg8::silu_mul(hgv[0][1][3], hgv[1][1][3]));
                        *(u32x4*)(Gb + (size_t)row * DFF + c) = w;
                    }
                  } }
                GSYNC();
                rA = (const char*)(a.ws + WS_G); rBoff = WS_WDN + (size_t)l * 5767168; rK = DFF;
                lng = a.in[l == 0 ? 11 : l == 1 ? 21 : l == 2 ? 36 : 48]; lnb = a.in[l == 0 ? 12 : l == 1 ? 22 : l == 2 ? 37 : 49];
            }
            { PHASE_VARS
              pg8::StaticOrder S; S.init(MROWS / 256, DM / 256, G, bid);
              pg8::MapStd MP{rA, (const char*)(ws + rBoff), (size_t)rK * 2, (size_t)rK * 2};
              pg8::PanelStats st{(unsigned*)(ws + 89 * MiB), (unsigned*)ws + 16384 + (l * 2 + h) * 128 * 64, ldsl + 131072 + 1024};
              const int q = 2 * l + h; bf16_t* XHo = (bf16_t*)OUT + (size_t)MROWS * DM;
              constexpr int QB16 = 3;
              pg8::EpiResidLn E{(GAS float*)(q == 7 ? OUT : nullptr), (GAS bf16_t*)(q == 7 ? nullptr : (bf16_t*)(ws + WS_XB)),
                                 (const GAS bf16_t*)(q <= QB16 ? (bf16_t*)(ws + WS_XB) : q == 7 ? (bf16_t*)(ws + WS_XH7) : XHo), (GAS bf16_t*)((q == 7 || q < QB16) ? nullptr : q == 6 ? (bf16_t*)(ws + WS_XH7) : XHo), (const GAS float*)rbias, (const GAS float*)lng, (const GAS float*)lnb, st, q <= QB16};
              pg8::gemm_phase<pg8::EpiResidLn, pg8::MapStd, true>(tid, ldsl, rK, rK, rK, MP, S, E); }
            GSYNC();
        }
    }
}

extern "C" void kernel_launch(void* const* d_in, const int* in_sizes, int n_in, void* d_out, int out_size, void* d_ws, size_t ws_size, hipStream_t stream) {
    static int grid = 0;
    if (grid == 0) {
        if (n_in != 50 || out_size != MROWS * DM || ws_size < WS_NEED) { fprintf(stderr, "kernel_launch: unexpected shapes n_in %d out %d ws %zu\n", n_in, out_size, ws_size); grid = -1; return; }
        int dev = 0, cus = 0, per_cu = 0;
        (void)hipGetDevice(&dev); (void)hipDeviceGetAttribute(&cus, hipDeviceAttributeMultiprocessorCount, dev);
        (void)hipFuncSetAttribute((const void*)mk_fwd, hipFuncAttributeMaxDynamicSharedMemorySize, LDS_BYTES);
        (void)hipOccupancyMaxActiveBlocksPerMultiprocessor(&per_cu, (const void*)mk_fwd, 512, LDS_BYTES);
        if (per_cu < 1) per_cu = 1;
        grid = cus * per_cu;
        fprintf(stderr, "kernel_launch: grid %d (cus %d x %d)\n", grid, cus, per_cu);
    }
    if (grid < 0) return;
    Args a{};
    for (int i = 0; i < 50; ++i) a.in[i] = (const float*)d_in[i];
    a.out = (float*)d_out; a.ws = (unsigned char*)d_ws;
    void* args[] = {&a};
    hipError_t e = hipLaunchCooperativeKernel((const void*)mk_fwd, dim3(grid), dim3(512), args, LDS_BYTES, stream);
    if (e != hipSuccess) fprintf(stderr, "cooperative launch failed: %s (grid %d)\n", hipGetErrorString(e), grid);
}
```
